# Optimizing an MI355X kernel written in HIP

```python
import jax
import jax.numpy as jnp
from jax import lax
import numpy as np

D_MODEL = 1024
BATCH = 8
SEQ = 4096
DEPTH = 1

EPS = 1e-6
ATTN_GROUPS = ((128, 1), (512, 4), (2048, 16))
N_GROUPS = 3
HEADS_PER_GROUP = 8
HEAD_DIM = 64
ATTN_WIDTH = HEADS_PER_GROUP * HEAD_DIM
N_ATTN_HEADS = N_GROUPS * HEADS_PER_GROUP
ATTN_QKV_COLS = N_GROUPS * 3 * ATTN_WIDTH
NUM_BUCKETS = 32
REL_MAX_DISTANCE = 1024
NEG_INF = -1e30
HG_HEADS = 8
HG_DK = D_MODEL // HG_HEADS
HG_DV = D_MODEL // HG_HEADS
HG_WIDTH = HG_HEADS * HG_DV
HG_CHUNK = 32
SPLIT_SIZES = (ATTN_QKV_COLS, ATTN_WIDTH, HG_WIDTH, HG_WIDTH, HG_WIDTH, HG_WIDTH, HG_WIDTH, D_MODEL, D_MODEL)
IN_COLS = ATTN_QKV_COLS + ATTN_WIDTH + 5 * HG_WIDTH + 2 * D_MODEL

kernel_name = "hybrid_dilated_attn_hgrn2_block"


def rms_norm(t, w):
    t32 = t.astype(jnp.float32)
    return t32 * lax.rsqrt(jnp.mean(t32 * t32, axis=-1, keepdims=True) + EPS) * w.astype(jnp.float32)


def t5_bucket(rel):
    half = NUM_BUCKETS // 2
    max_exact = half // 2
    n = np.abs(rel)
    large = max_exact + (np.log(np.maximum(n, 1) / max_exact)
                         / np.log(REL_MAX_DISTANCE / max_exact) * (half - max_exact)).astype(np.int32)
    large = np.minimum(large, half - 1)
    return np.where(rel > 0, half, 0) + np.where(n < max_exact, n, large)


def dilated_window_attention(q, k, v, bias_table, window, dilation):
    B, S, H, Dh = q.shape
    side = (window // 2) // dilation
    blk = side
    L = S // dilation
    nb = -(-L // blk)
    Lp = nb * blk

    def to_blocks(t):
        t = t.reshape(B, L, dilation, H, Dh)
        t = jnp.pad(t, ((0, 0), (0, Lp - L), (0, 0), (0, 0), (0, 0)))
        return t.reshape(B, nb, blk, dilation, H, Dh)

    def with_halo(t):
        tp = jnp.pad(t, ((0, 0), (1, 1), (0, 0), (0, 0), (0, 0), (0, 0)))
        return jnp.concatenate([tp[:, :-2], tp[:, 1:-1], tp[:, 2:]], axis=2)

    def from_blocks(t):
        t = t.reshape((B, Lp) + t.shape[3:])[:, :L]
        return t.reshape((B, S) + t.shape[3:])

    qb = to_blocks(q) * (HEAD_DIM ** -0.5)
    kh = with_halo(to_blocks(k))
    vh = with_halo(to_blocks(v))

    i_idx = np.arange(blk)[:, None]
    j_idx = np.arange(3 * blk)[None, :]
    rel = j_idx - blk - i_idx
    bias = jnp.transpose(bias_table[t5_bucket(rel * dilation)], (2, 0, 1))
    t_key = np.arange(nb)[:, None, None] * blk - blk + j_idx[None]
    valid = (np.abs(rel)[None] <= side) & (t_key >= 0) & (t_key < L)

    s = jnp.einsum('bnqrhd,bnkrhd->bnrhqk', qb, kh) + bias
    s = jnp.where(valid[None, :, None, None], s, NEG_INF)
    m = jnp.max(s, axis=-1, keepdims=True)
    p = jnp.exp(s - m)
    den = jnp.transpose(jnp.sum(p, axis=-1), (0, 1, 4, 2, 3))
    o = jnp.einsum('bnrhqk,bnkrhd->bnqrhd', p, vh) / den[..., None]
    m = jnp.transpose(m[..., 0], (0, 1, 4, 2, 3))
    return from_blocks(o), from_blocks(m), from_blocks(den)


def gla_chunk_scan(q, k, v, log_f):
    B, T, H, DK = q.shape
    DV = v.shape[-1]
    N = T // HG_CHUNK

    def chunks(t):
        return t.reshape(B, N, HG_CHUNK, H, t.shape[-1]).transpose(1, 0, 3, 2, 4)

    qc, kc, vc, gc = chunks(q), chunks(k), chunks(v), chunks(log_f)
    b = jnp.cumsum(gc, axis=3)
    b_last = b[:, :, :, -1, :]
    q_t = qc * jnp.exp(b)
    k_t = kc * jnp.exp(-b)
    k_s = kc * jnp.exp(b_last[:, :, :, None, :] - b)
    lower = jnp.tril(jnp.ones((HG_CHUNK, HG_CHUNK), dtype=bool))
    a = jnp.where(lower, jnp.einsum('nbhik,nbhjk->nbhij', q_t, k_t), 0.0)
    o_intra = jnp.einsum('nbhij,nbhjv->nbhiv', a, vc)

    def step(state, xs):
        q_n, k_n, v_n, dec_n = xs
        o_n = jnp.einsum('bhik,bhkv->bhiv', q_n, state)
        state = dec_n[..., None] * state + jnp.einsum('bhik,bhiv->bhkv', k_n, v_n)
        return state, o_n

    s0 = jnp.zeros((B, H, DK, DV), jnp.float32)
    _, o_inter = lax.scan(step, s0, (q_t, k_s, vc, jnp.exp(b_last)))
    o = o_intra + o_inter
    return o.transpose(1, 0, 3, 2, 4).reshape(B, T, H, DV)


def hgrn2_scan(q, i, z_f, lb):
    f = lb + (1.0 - lb) * jax.nn.sigmoid(z_f)
    return gla_chunk_scan(q, 1.0 - f, i, jnp.log(f))


def setup_inputs(seed: int = 0) -> dict:
    key = jax.random.key(seed)
    ks = jax.random.split(key, 12)
    f32 = jnp.float32
    nrm = jax.random.normal
    return {
        "x": nrm(ks[0], (BATCH, SEQ, D_MODEL), f32),
        "norm_w": 1.0 + 0.02 * nrm(ks[1], (DEPTH, D_MODEL), f32),
        "w_in": nrm(ks[2], (DEPTH, D_MODEL, IN_COLS), f32) * D_MODEL ** -0.5,
        "q_norm_w": 1.0 + 0.02 * nrm(ks[3], (DEPTH, N_GROUPS, HEAD_DIM), f32),
        "k_norm_w": 1.0 + 0.02 * nrm(ks[4], (DEPTH, N_GROUPS, HEAD_DIM), f32),
        "rel_bias": 0.5 * nrm(ks[5], (NUM_BUCKETS, N_ATTN_HEADS), f32),
        "lb_fwd": 0.1 * nrm(ks[6], (DEPTH + 1, HG_HEADS * HG_DK), f32),
        "lb_bwd": 0.1 * nrm(ks[7], (DEPTH + 1, HG_HEADS * HG_DK), f32),
        "hg_norm_w": 1.0 + 0.02 * nrm(ks[8], (DEPTH, HG_DV), f32),
        "w_proj_a": nrm(ks[9], (DEPTH, ATTN_WIDTH, D_MODEL), f32) * ATTN_WIDTH ** -0.5,
        "w_proj_b": nrm(ks[10], (DEPTH, HG_WIDTH, D_MODEL), f32) * HG_WIDTH ** -0.5,
        "w_out": nrm(ks[11], (DEPTH, D_MODEL, D_MODEL), f32) * D_MODEL ** -0.5,
    }


def reference(x, norm_w, w_in, q_norm_w, k_norm_w, rel_bias, lb_fwd, lb_bwd, hg_norm_w,
              w_proj_a, w_proj_b, w_out):
    f32 = jnp.float32
    B, S, _ = x.shape
    split_points = np.cumsum(SPLIT_SIZES)[:-1].tolist()
    lb_f_all = jnp.cumsum(jax.nn.softmax(lb_fwd.astype(f32), axis=0), axis=0)
    lb_b_all = jnp.cumsum(jax.nn.softmax(lb_bwd.astype(f32), axis=0), axis=0)
    bias_tab = rel_bias.astype(f32)
    h_res = x.astype(f32)
    for layer in range(DEPTH):
        h = rms_norm(h_res, norm_w[layer])
        z = jnp.einsum('bsd,dc->bsc', h, w_in[layer].astype(f32))
        qkv_a, g_a, q_b, zf_fwd, zf_bwd, i_b, g_b, zgate_a, zgate_b = jnp.split(z, split_points, axis=-1)

        qkv_a = qkv_a.reshape(B, S, N_GROUPS, 3, HEADS_PER_GROUP, HEAD_DIM)
        outs, maxes, dens = [], [], []
        for g, (window, dilation) in enumerate(ATTN_GROUPS):
            q = rms_norm(qkv_a[:, :, g, 0], q_norm_w[layer, g])
            k = rms_norm(qkv_a[:, :, g, 1], k_norm_w[layer, g])
            v = qkv_a[:, :, g, 2]
            o_g, m_g, d_g = dilated_window_attention(
                q, k, v, bias_tab[:, g * HEADS_PER_GROUP:(g + 1) * HEADS_PER_GROUP], window, dilation)
            outs.append(o_g)
            maxes.append(m_g)
            dens.append(d_g)
        m_all = jnp.stack(maxes)
        wts = jnp.stack(dens) * jnp.exp(m_all - jnp.max(m_all, axis=0, keepdims=True))
        o_a = jnp.sum(wts[..., None] * jnp.stack(outs), axis=0) / jnp.sum(wts, axis=0)[..., None]
        y_a = jnp.einsum('bsc,cd->bsd', o_a.reshape(B, S, ATTN_WIDTH) * jax.nn.silu(g_a),
                         w_proj_a[layer].astype(f32))

        q_b = q_b.reshape(B, S, HG_HEADS, HG_DK)
        i_b = i_b.reshape(B, S, HG_HEADS, HG_DV)
        zf_fwd = zf_fwd.reshape(B, S, HG_HEADS, HG_DK)
        zf_bwd = zf_bwd.reshape(B, S, HG_HEADS, HG_DK)
        lb_f = lb_f_all[layer].reshape(HG_HEADS, HG_DK)
        lb_b = lb_b_all[layer].reshape(HG_HEADS, HG_DK)
        o_fwd = hgrn2_scan(q_b, i_b, zf_fwd, lb_f)
        o_bwd = jnp.flip(hgrn2_scan(jnp.flip(q_b, 1), jnp.flip(i_b, 1), jnp.flip(zf_bwd, 1), lb_b), 1)
        o_b = rms_norm(o_fwd + o_bwd, hg_norm_w[layer]) * jax.nn.silu(g_b.reshape(B, S, HG_HEADS, HG_DV))
        y_b = jnp.einsum('bsc,cd->bsd', o_b.reshape(B, S, HG_WIDTH), w_proj_b[layer].astype(f32))

        merged = jax.nn.sigmoid(zgate_a) * y_a + jax.nn.sigmoid(zgate_b) * y_b
        h_res = h_res + jnp.einsum('bsd,de->bse', merged, w_out[layer].astype(f32))
    return h_res.astype(x.dtype)
```

```cpp
#include <hip/hip_runtime.h>
#include <hip/hip_cooperative_groups.h>
#include <cstdio>
#include <cstdint>
namespace cg = cooperative_groups;

#define LAS __attribute__((address_space(3)))
#define GAS __attribute__((address_space(1)))
typedef unsigned short bf16_t;
typedef short bf16x8 __attribute__((ext_vector_type(8)));
typedef float f32x4 __attribute__((ext_vector_type(4)));
typedef float f32x2 __attribute__((ext_vector_type(2)));
typedef unsigned u32x4 __attribute__((ext_vector_type(4)));
typedef unsigned u32x2 __attribute__((ext_vector_type(2)));

__device__ __forceinline__ int lane_fresh() { int z = 0; asm volatile("" : "+v"(z)); return (int)__builtin_amdgcn_mbcnt_hi(~0u, __builtin_amdgcn_mbcnt_lo(~0u, (unsigned)z)); }
__device__ __forceinline__ int tid_local(int wid_s) { return (wid_s << 6) | lane_fresh(); }

#define REP_P0 1
#define REP_P1 1
#define REP_ATT 1
#define REP_MRG 1
#define REP_SCA 1
#define REP_SCC 1
#define REP_P3 1
#define REP_P4 1
#define REP_SYNC 1
#define STAGGER 0
#define P1_ALIGN true
#define COVER_P1 false
#define REP_SCB 1
#define REP_SCF 1
#define SC_E2 0
#define SC_M2 0
#define SC_D2 0

constexpr int NBATCH = 8, SEQ = 4096, DM = 1024, MTOK = NBATCH * SEQ;
constexpr int INCOLS = 12288;
constexpr float LOG2E = 1.4426950408889634f;
constexpr int NTHREADS = 512, NWAVES = 8;
constexpr int LDS_BYTES = 163840;
constexpr int LDS_XB_OFF = 163776;

constexpr size_t MiB = 1u << 20;
constexpr size_t WS_WIN = 1 * MiB;
constexpr size_t WS_WA = 25 * MiB;
constexpr size_t WS_WB = 26 * MiB;
constexpr size_t WS_WO = 28 * MiB;
constexpr size_t WS_H = 32 * MiB;
constexpr size_t WS_X = 96 * MiB;
constexpr size_t WS_QKV = WS_X;
constexpr size_t WS_GA = 448 * MiB;
constexpr size_t WS_HG = WS_X;
constexpr size_t WS_GB = WS_X + 256 * MiB;
constexpr size_t WS_MG = WS_X;
constexpr size_t WS_T1 = WS_X + 64 * MiB, WS_T2 = WS_X + 128 * MiB;
constexpr size_t WS_A1 = 416 * MiB;
constexpr size_t WS_A2 = 448 * MiB;
constexpr size_t WS_END = 512 * MiB;

namespace pg8 {
constexpr int BM = 256, BK = 64, HALF = 128, HTB = HALF * BK * 2, STAGE_BYTES = 8 * HTB, NXCD = 8, WGM = 4;
__host__ __device__ __forceinline__ int lds_byte(int r, int c) { const int st = (r >> 4) * 2 + (c >> 5), rr = r & 15, cc = c & 31, ob = rr * 64 + cc * 2; return st * 1024 + (ob ^ (((ob >> 9) & 1) << 5)); }
__host__ __device__ __forceinline__ void stage_rc(int b, int& R, int& C) { const int st = b / 1024, sb = b % 1024, swz = sb ^ (((sb >> 9) & 1) << 5); R = (st >> 1) * 16 + swz / 64; C = (st & 1) * 32 + (swz % 64) / 2; }
struct Unit { int pm, pn; };
struct Gemm { const bf16_t* A; const bf16_t* Bt; int M, N, K; int stg = 0; };
struct StaticOrder {
    int nM, nN, nwg, G, c;
    __host__ __device__ void init(int M, int N, int G_, int c_) { nM = M / BM; nN = N / BM; nwg = nM * nN; G = G_; c = c_; }
    __host__ __device__ bool next(int i, Unit& u) const {
        const long L = (long)i * G + c; if (L >= nwg) return false;
        int wgid = (int)L; { const int q = nwg / NXCD, r = nwg % NXCD, xcd = wgid % NXCD, off = wgid / NXCD; wgid = (xcd < r ? xcd * (q + 1) : r * (q + 1) + (xcd - r) * q) + off; }
        const int nig = WGM * nN, gid = wgid / nig, fm = gid * WGM, gsz = (nM - fm) < WGM ? (nM - fm) : WGM;
        u.pm = fm + ((wgid % nig) % gsz); u.pn = (wgid % nig) / gsz; return true;
    }
    __device__ __forceinline__ void a_ready(const Unit&) const {}
    __device__ __forceinline__ void done(const Unit&) const {}
};
typedef __bf16 bf16x2v_t __attribute__((ext_vector_type(2)));
struct GateOrder : StaticOrder {
    __device__ bool next(int i, Unit& u) const { if (!StaticOrder::next(i >> 1, u)) return false; u.pn += 4 * ((i & 1) ^ 1); return true; }
};
__device__ __forceinline__ unsigned cvt_pk_bf16(float lo, float hi) { f32x2 v = {lo, hi}; bf16x2v_t b = __builtin_convertvector(v, bf16x2v_t); return __builtin_bit_cast(unsigned, b); }

template <class Epi, class Sched, bool ALIGN_EPI = false, bool SP2 = false, bool COVER = false>
__device__ __forceinline__ void gemm_phase(LAS unsigned char* lds, const Gemm g, const Sched& S, const Epi& E, int wid_s) {
    const int tid = tid_local(wid_s), wid = __builtin_amdgcn_readfirstlane(tid >> 6), lane = tid & 63, wr = wid >> 2, wc = wid & 3, fr = lane & 15, fq = lane >> 4;
    const int K = g.K, nt = K / BK;
    unsigned voffA, voffB;
    { int R, C; stage_rc(tid * 16, R, C); voffA = (unsigned)(R * K + C) * 2u; voffB = voffA; }
    const size_t rstep = (size_t)64 * K * 2;
    const size_t kstep = (size_t)(BK * 2);
    const size_t hstep = (size_t)HALF * K * 2;
    const size_t tstep = 2 * hstep;
    const unsigned ldsw = (unsigned)wid * 1024u;
    const int aoff = lds_byte(wr * 64 + fr, fq * 8), boff = lds_byte(wc * 32 + fr, fq * 8);
#define PG8_SA(b, h) (((b) * 2 + (h)) * HTB)
#define PG8_SB(b, h) ((4 + (b) * 2 + (h)) * HTB)
#define PG8_STAGE(bufoff, gbase, voff) do { _Pragma("unroll") for (int _i = 0; _i < 2; ++_i) \
        __builtin_amdgcn_global_load_lds((const unsigned*)((const char*)(gbase) + _i * rstep + (voff)), (LAS unsigned*)(lds + (bufoff) + ldsw + _i * 8192), 16, 0, 0); } while (0)
#define PG8_LDA(dst, b, h) do { _Pragma("unroll") for (int m = 0; m < 4; ++m) _Pragma("unroll") for (int k = 0; k < 2; ++k) dst[m][k] = *(const LAS bf16x8*)(lds + PG8_SA(b, h) + aoff + m * 2048 + k * 1024); } while (0)
#define PG8_LDB(dst, b, h) do { _Pragma("unroll") for (int n = 0; n < 2; ++n) _Pragma("unroll") for (int k = 0; k < 2; ++k) dst[n][k] = *(const LAS bf16x8*)(lds + PG8_SB(b, h) + boff + n * 2048 + k * 1024); } while (0)
#define PG8_MMA(ai, bj, At, Bt) do { __builtin_amdgcn_s_setprio(3); _Pragma("unroll") for (int m = 0; m < 4; ++m) _Pragma("unroll") for (int n = 0; n < 2; ++n) _Pragma("unroll") for (int k = 0; k < 2; ++k) \
        acc[ai][bj][m][n] = __builtin_amdgcn_mfma_f32_16x16x32_bf16(Bt[n][k], At[m][k], acc[ai][bj][m][n], 0, 0, 0); __builtin_amdgcn_s_setprio(0); } while (0)
#define PG8_MMAZ(ai, bj, At, Bt, FIRST) do { __builtin_amdgcn_s_setprio(3); \
        if (FIRST) { _Pragma("unroll") for (int m = 0; m < 4; ++m) _Pragma("unroll") for (int n = 0; n < 2; ++n) acc[ai][bj][m][n] = __builtin_amdgcn_mfma_f32_16x16x32_bf16(Bt[n][0], At[m][0], (f32x4){0.f, 0.f, 0.f, 0.f}, 0, 0, 0); } \
        else { _Pragma("unroll") for (int m = 0; m < 4; ++m) _Pragma("unroll") for (int n = 0; n < 2; ++n) acc[ai][bj][m][n] = __builtin_amdgcn_mfma_f32_16x16x32_bf16(Bt[n][0], At[m][0], acc[ai][bj][m][n], 0, 0, 0); } \
        _Pragma("unroll") for (int m = 0; m < 4; ++m) _Pragma("unroll") for (int n = 0; n < 2; ++n) acc[ai][bj][m][n] = __builtin_amdgcn_mfma_f32_16x16x32_bf16(Bt[n][1], At[m][1], acc[ai][bj][m][n], 0, 0, 0); \
        __builtin_amdgcn_s_setprio(0); } while (0)
#define PG8_WAIT_V(n) asm volatile("s_waitcnt vmcnt(" #n ")" ::: "memory")
#define PG8_WAIT_L(n) asm volatile("s_waitcnt lgkmcnt(" #n ")" ::: "memory")
#define PG8_BAR __builtin_amdgcn_s_barrier()
#define PG8_SCHED __builtin_amdgcn_sched_barrier(0)
    if (g.stg) { const int d = (S.c & 7) * g.stg; for (int q = 0; q < d; ++q) __builtin_amdgcn_s_sleep(127); }
    Unit cur, nxt; int ui = 0;
    if (!S.next(0, cur)) return;
    f32x4 acc[2][2][4][2];
#pragma unroll
    for (int a = 0; a < 2; ++a)
#pragma unroll
        for (int b = 0; b < 2; ++b)
#pragma unroll
            for (int m = 0; m < 4; ++m)
#pragma unroll
                for (int n = 0; n < 2; ++n) acc[a][b][m][n] = (f32x4){0.f, 0.f, 0.f, 0.f};
    bf16x8 At[4][2], B0[2][2], B1[2][2];
    const char* cA = (const char*)g.A + (size_t)cur.pm * tstep; const char* cB = (const char*)g.Bt + (size_t)cur.pn * tstep;
    S.a_ready(cur);
    if constexpr (SP2) {
        PG8_STAGE(PG8_SB(0, 0), cB, voffB); PG8_STAGE(PG8_SB(0, 1), cB + hstep, voffB); PG8_STAGE(PG8_SA(0, 0), cA, voffA); PG8_STAGE(PG8_SA(0, 1), cA + hstep, voffA);
        if (wr == 1) PG8_BAR;
        PG8_WAIT_V(2); PG8_BAR;
        PG8_STAGE(PG8_SB(1, 0), cB + kstep, voffB); PG8_STAGE(PG8_SA(1, 0), cA + kstep, voffA); PG8_STAGE(PG8_SB(1, 1), cB + hstep + kstep, voffB);
        if constexpr (COVER) { PG8_STAGE(PG8_SA(1, 1), cA + hstep + kstep, voffA); PG8_WAIT_V(0); } else PG8_WAIT_V(6);
        PG8_BAR;
    } else {
        PG8_STAGE(PG8_SB(0, 0), cB, voffB); PG8_STAGE(PG8_SA(0, 0), cA, voffA); PG8_STAGE(PG8_SB(0, 1), cB + hstep, voffB); PG8_STAGE(PG8_SA(0, 1), cA + hstep, voffA);
        if (wr == 1) PG8_BAR;
        PG8_WAIT_V(4); PG8_BAR;
        PG8_STAGE(PG8_SB(1, 0), cB + kstep, voffB); PG8_STAGE(PG8_SA(1, 0), cA + kstep, voffA); PG8_STAGE(PG8_SB(1, 1), cB + hstep + kstep, voffB);
        PG8_WAIT_V(6); PG8_BAR;
    }
    for (;;) {
        const bool has_next = S.next(ui + 1, nxt);
        const char* nA = has_next ? (const char*)g.A + (size_t)nxt.pm * tstep : cA; const char* nB = has_next ? (const char*)g.Bt + (size_t)nxt.pn * tstep : cB;
#define PG8_TRIP_SP2(T0) do { \
            PG8_LDB(B0, 0, 0); PG8_LDB(B1, 0, 1); PG8_SCHED; PG8_LDA(At, 0, 0); if (!(T0)) PG8_STAGE(PG8_SA(1, 1), a1 + hstep, voffA); \
            if (T0) PG8_WAIT_V(24); else PG8_WAIT_V(8); PG8_WAIT_L(0); PG8_BAR; PG8_MMAZ(0, 0, At, B0, t == 0); PG8_MMAZ(0, 1, At, B1, t == 0); PG8_BAR; PG8_SCHED; \
            PG8_LDA(At, 0, 1); PG8_STAGE(PG8_SB(0, 0), b2, voffB); PG8_STAGE(PG8_SB(0, 1), b2 + hstep, voffB); PG8_STAGE(PG8_SA(0, 0), a2, voffA); \
            if (T0) PG8_WAIT_V(24); else PG8_WAIT_V(8); PG8_WAIT_L(0); PG8_BAR; PG8_MMAZ(1, 0, At, B0, t == 0); PG8_MMAZ(1, 1, At, B1, t == 0); PG8_BAR; PG8_SCHED; \
            PG8_LDB(B0, 1, 0); PG8_LDB(B1, 1, 1); PG8_SCHED; PG8_LDA(At, 1, 0); PG8_STAGE(PG8_SA(0, 1), a2 + hstep, voffA); \
            if (T0) PG8_WAIT_V(24); else PG8_WAIT_V(8); PG8_WAIT_L(0); PG8_BAR; PG8_MMA(0, 0, At, B0); PG8_MMA(0, 1, At, B1); PG8_BAR; PG8_SCHED; \
            PG8_LDA(At, 1, 1); PG8_STAGE(PG8_SB(1, 0), b3, voffB); PG8_STAGE(PG8_SB(1, 1), b3 + hstep, voffB); PG8_STAGE(PG8_SA(1, 0), a3, voffA); \
            PG8_WAIT_V(8); PG8_WAIT_L(0); PG8_BAR; PG8_MMA(1, 0, At, B0); PG8_MMA(1, 1, At, B1); PG8_BAR; PG8_SCHED; } while (0)
        if constexpr (SP2 && COVER) {
            { const int t = 0; const char* a1 = cA + kstep; const char* a2 = cA + 2 * kstep; const char* b2 = cB + 2 * kstep; const char* a3 = a2 + kstep; const char* b3 = b2 + kstep; (void)a1;
              PG8_TRIP_SP2(true); }
        }
        for (int t = (SP2 && COVER) ? 2 : 0; t < nt; t += 2) {
            const bool last = (t == nt - 2);
            const char* a1 = cA + (size_t)(t + 1) * kstep;
            const char* a2 = last ? nA : cA + (size_t)(t + 2) * kstep; const char* b2 = last ? nB : cB + (size_t)(t + 2) * kstep;
            const char* a3 = a2 + kstep; const char* b3 = b2 + kstep;
            if (last && has_next) S.a_ready(nxt);
            if constexpr (SP2) {
            PG8_TRIP_SP2(false);
            } else {
            PG8_LDB(B0, 0, 0); PG8_SCHED; PG8_LDA(At, 0, 0); PG8_STAGE(PG8_SA(1, 1), a1 + hstep, voffA);
            PG8_WAIT_L(8); PG8_BAR; PG8_WAIT_L(0); PG8_MMA(0, 0, At, B0); PG8_BAR; PG8_SCHED;
            PG8_LDB(B1, 0, 1); PG8_STAGE(PG8_SB(0, 0), b2, voffB);
            PG8_BAR; PG8_WAIT_L(0); PG8_MMA(0, 1, At, B1); PG8_BAR;
            PG8_LDA(At, 0, 1); PG8_STAGE(PG8_SA(0, 0), a2, voffA);
            PG8_BAR; PG8_WAIT_L(0); PG8_MMA(1, 0, At, B0); PG8_BAR; PG8_SCHED;
            PG8_STAGE(PG8_SB(0, 1), b2 + hstep, voffB);
            PG8_WAIT_V(6); PG8_BAR; PG8_MMA(1, 1, At, B1); PG8_BAR;
            PG8_LDB(B0, 1, 0); PG8_SCHED; PG8_LDA(At, 1, 0); PG8_STAGE(PG8_SA(0, 1), a2 + hstep, voffA);
            PG8_WAIT_L(8); PG8_BAR; PG8_WAIT_L(0); PG8_MMA(0, 0, At, B0); PG8_BAR; PG8_SCHED;
            PG8_LDB(B1, 1, 1); PG8_STAGE(PG8_SB(1, 0), b3, voffB);
            PG8_BAR; PG8_WAIT_L(0); PG8_MMA(0, 1, At, B1); PG8_BAR;
            PG8_LDA(At, 1, 1); PG8_STAGE(PG8_SA(1, 0), a3, voffA);
            PG8_BAR; PG8_WAIT_L(0); PG8_MMA(1, 0, At, B0); PG8_BAR; PG8_SCHED;
            PG8_STAGE(PG8_SB(1, 1), b3 + hstep, voffB);
            PG8_WAIT_V(6); PG8_BAR; PG8_MMA(1, 1, At, B1); PG8_BAR;
            }
        }
        if constexpr (ALIGN_EPI) { if (wr == 0) PG8_BAR; }
        if constexpr (COVER) { PG8_STAGE(PG8_SA(1, 1), nA + hstep + kstep, voffA); asm volatile("" ::: "memory"); }
        { const int le = lane_fresh(); E(acc, cur, wr, wc, le & 15, le >> 4); } S.done(cur);
        if (!has_next) break;
        if constexpr (!SP2) {
#pragma unroll
        for (int a = 0; a < 2; ++a)
#pragma unroll
            for (int b = 0; b < 2; ++b)
#pragma unroll
                for (int m = 0; m < 4; ++m)
#pragma unroll
                    for (int n = 0; n < 2; ++n) acc[a][b][m][n] = (f32x4){0.f, 0.f, 0.f, 0.f};
        }
        cur = nxt; cA = nA; cB = nB; ++ui;
        if constexpr (ALIGN_EPI) { if (wr == 1) PG8_BAR; }
    }
    PG8_WAIT_V(0);
    if constexpr (!ALIGN_EPI) { if (wr == 0) PG8_BAR; }
    PG8_BAR;
#undef PG8_SA
#undef PG8_SB
#undef PG8_STAGE
#undef PG8_LDA
#undef PG8_LDB
#undef PG8_MMA
#undef PG8_WAIT_V
#undef PG8_WAIT_L
#undef PG8_BAR
#undef PG8_SCHED
#undef PG8_TRIP_SP2
#undef PG8_MMAZ
}
struct Gemm2 { const bf16_t* A[2]; const bf16_t* Bt[2]; int K[2]; };
__device__ __forceinline__ const char* uni64(const char* p) {
    const unsigned long long v = (unsigned long long)p;
    const unsigned lo = (unsigned)__builtin_amdgcn_readfirstlane((int)(unsigned)v), hi = (unsigned)__builtin_amdgcn_readfirstlane((int)(unsigned)(v >> 32));
    return (const char*)(((unsigned long long)hi << 32) | lo); }
template <class Epi, class Sched>
__device__ __forceinline__ void gemm_phase2(LAS unsigned char* lds, const Gemm2 g, const Sched& S, const Epi& E, int wid_s) {
    const int tid = tid_local(wid_s), wid = __builtin_amdgcn_readfirstlane(tid >> 6), lane = tid & 63, wr = wid >> 2, wc = wid & 3, fr = lane & 15, fq = lane >> 4;
    unsigned R2, C2;
    { int R, C; stage_rc(tid * 16, R, C); R2 = (unsigned)R * 2u; C2 = (unsigned)C * 2u; }
    const size_t kstep = (size_t)(BK * 2);
    const unsigned ldsw = (unsigned)wid * 1024u;
    const int aoff = lds_byte(wr * 64 + fr, fq * 8), boff = lds_byte(wc * 32 + fr, fq * 8);
#define PG8_SA(b, h) (((b) * 2 + (h)) * HTB)
#define PG8_SB(b, h) ((4 + (b) * 2 + (h)) * HTB)
#define PG8_STAGE2(bufoff, gbase, KK) do { const char* _gb = (const char*)(gbase); const unsigned _k = (unsigned)(KK); const unsigned _vo = R2 * _k + C2; \
        __builtin_amdgcn_global_load_lds((const unsigned*)(_gb + _vo), (LAS unsigned*)(lds + (bufoff) + ldsw), 16, 0, 0); \
        __builtin_amdgcn_global_load_lds((const unsigned*)(_gb + (size_t)128 * _k + _vo), (LAS unsigned*)(lds + (bufoff) + ldsw + 8192), 16, 0, 0); } while (0)
#define PG8_LDA(dst, b, h) do { _Pragma("unroll") for (int m = 0; m < 4; ++m) _Pragma("unroll") for (int k = 0; k < 2; ++k) dst[m][k] = *(const LAS bf16x8*)(lds + PG8_SA(b, h) + aoff + m * 2048 + k * 1024); } while (0)
#define PG8_LDB(dst, b, h) do { _Pragma("unroll") for (int n = 0; n < 2; ++n) _Pragma("unroll") for (int k = 0; k < 2; ++k) dst[n][k] = *(const LAS bf16x8*)(lds + PG8_SB(b, h) + boff + n * 2048 + k * 1024); } while (0)
#define PG8_MMA(ai, bj, At, Bt) do { __builtin_amdgcn_s_setprio(3); _Pragma("unroll") for (int m = 0; m < 4; ++m) _Pragma("unroll") for (int n = 0; n < 2; ++n) _Pragma("unroll") for (int k = 0; k < 2; ++k) \
        acc[ai][bj][m][n] = __builtin_amdgcn_mfma_f32_16x16x32_bf16(Bt[n][k], At[m][k], acc[ai][bj][m][n], 0, 0, 0); __builtin_amdgcn_s_setprio(0); } while (0)
#define PG8_MMAZ(ai, bj, At, Bt, FIRST) do { __builtin_amdgcn_s_setprio(3); \
        if (FIRST) { _Pragma("unroll") for (int m = 0; m < 4; ++m) _Pragma("unroll") for (int n = 0; n < 2; ++n) acc[ai][bj][m][n] = __builtin_amdgcn_mfma_f32_16x16x32_bf16(Bt[n][0], At[m][0], (f32x4){0.f, 0.f, 0.f, 0.f}, 0, 0, 0); } \
        else { _Pragma("unroll") for (int m = 0; m < 4; ++m) _Pragma("unroll") for (int n = 0; n < 2; ++n) acc[ai][bj][m][n] = __builtin_amdgcn_mfma_f32_16x16x32_bf16(Bt[n][0], At[m][0], acc[ai][bj][m][n], 0, 0, 0); } \
        _Pragma("unroll") for (int m = 0; m < 4; ++m) _Pragma("unroll") for (int n = 0; n < 2; ++n) acc[ai][bj][m][n] = __builtin_amdgcn_mfma_f32_16x16x32_bf16(Bt[n][1], At[m][1], acc[ai][bj][m][n], 0, 0, 0); \
        __builtin_amdgcn_s_setprio(0); } while (0)
#define PG8_WAIT_V(n) asm volatile("s_waitcnt vmcnt(" #n ")" ::: "memory")
#define PG8_WAIT_L(n) asm volatile("s_waitcnt lgkmcnt(" #n ")" ::: "memory")
#define PG8_BAR __builtin_amdgcn_s_barrier()
#define PG8_SCHED __builtin_amdgcn_sched_barrier(0)
    Unit cur, nxt; int ui = 0, seg = 0;
    if (!S.next(0, cur)) return;
    f32x4 acc[2][2][4][2];
#pragma unroll
    for (int a = 0; a < 2; ++a)
#pragma unroll
        for (int b = 0; b < 2; ++b)
#pragma unroll
            for (int m = 0; m < 4; ++m)
#pragma unroll
                for (int n = 0; n < 2; ++n) acc[a][b][m][n] = (f32x4){0.f, 0.f, 0.f, 0.f};
    bf16x8 At[4][2], B0[2][2], B1[2][2];
    size_t hs = (size_t)HALF * g.K[0] * 2;
    int ck = g.K[0];
    const char* cA = (const char*)g.A[0] + (size_t)cur.pm * 2 * hs; const char* cB = (const char*)g.Bt[0] + (size_t)cur.pn * 2 * hs;
    PG8_STAGE2(PG8_SB(0, 0), cB, ck); PG8_STAGE2(PG8_SB(0, 1), cB + hs, ck); PG8_STAGE2(PG8_SA(0, 0), cA, ck); PG8_STAGE2(PG8_SA(0, 1), cA + hs, ck);
    if (wr == 1) PG8_BAR;
    PG8_WAIT_V(2); PG8_BAR;
    PG8_STAGE2(PG8_SB(1, 0), cB + kstep, ck); PG8_STAGE2(PG8_SA(1, 0), cA + kstep, ck); PG8_STAGE2(PG8_SB(1, 1), cB + hs + kstep, ck);
    PG8_WAIT_V(6); PG8_BAR;
    for (;;) {
        bool has_next; const int nseg = seg ^ 1;
        if (seg == 0) { has_next = true; nxt = cur; } else has_next = S.next(ui + 1, nxt);
        const int fseg = has_next ? nseg : seg;
        const size_t nhs = (size_t)HALF * (fseg ? g.K[1] : g.K[0]) * 2;
        const int nk = fseg ? g.K[1] : g.K[0];
        const char* nA = has_next ? (const char*)(fseg ? g.A[1] : g.A[0]) + (size_t)nxt.pm * 2 * nhs : cA;
        const char* nB = has_next ? (const char*)(fseg ? g.Bt[1] : g.Bt[0]) + (size_t)nxt.pn * 2 * nhs : cB;
        const int nt = (seg ? g.K[1] : g.K[0]) / BK;
        for (int t = 0; t < nt; t += 2) {
            const bool last = (t == nt - 2);
            const char* a1 = cA + (size_t)(t + 1) * kstep;
            const char* a2 = last ? nA : cA + (size_t)(t + 2) * kstep; const char* b2 = last ? nB : cB + (size_t)(t + 2) * kstep;
            const char* a3 = a2 + kstep; const char* b3 = b2 + kstep;
            const size_t h2 = last ? nhs : hs; const int wk = last ? nk : ck;
            const bool fresh = (t == 0) && (seg == 0);
            PG8_LDB(B0, 0, 0); PG8_LDB(B1, 0, 1); PG8_SCHED; PG8_LDA(At, 0, 0); PG8_STAGE2(PG8_SA(1, 1), a1 + hs, ck);
            PG8_WAIT_V(8); PG8_WAIT_L(0); PG8_BAR; PG8_MMAZ(0, 0, At, B0, fresh); PG8_MMAZ(0, 1, At, B1, fresh); PG8_BAR; PG8_SCHED;
            PG8_LDA(At, 0, 1); PG8_STAGE2(PG8_SB(0, 0), b2, wk); PG8_STAGE2(PG8_SB(0, 1), b2 + h2, wk); PG8_STAGE2(PG8_SA(0, 0), a2, wk);
            PG8_WAIT_V(8); PG8_WAIT_L(0); PG8_BAR; PG8_MMAZ(1, 0, At, B0, fresh); PG8_MMAZ(1, 1, At, B1, fresh); PG8_BAR; PG8_SCHED;
            PG8_LDB(B0, 1, 0); PG8_LDB(B1, 1, 1); PG8_SCHED; PG8_LDA(At, 1, 0); PG8_STAGE2(PG8_SA(0, 1), a2 + h2, wk);
            PG8_WAIT_V(8); PG8_WAIT_L(0); PG8_BAR; PG8_MMA(0, 0, At, B0); PG8_MMA(0, 1, At, B1); PG8_BAR; PG8_SCHED;
            PG8_LDA(At, 1, 1); PG8_STAGE2(PG8_SB(1, 0), b3, wk); PG8_STAGE2(PG8_SB(1, 1), b3 + h2, wk); PG8_STAGE2(PG8_SA(1, 0), a3, wk);
            PG8_WAIT_V(8); PG8_WAIT_L(0); PG8_BAR; PG8_MMA(1, 0, At, B0); PG8_MMA(1, 1, At, B1); PG8_BAR; PG8_SCHED;
        }
        if (wr == 0) PG8_BAR;
        { const int le = lane_fresh();
          if (seg == 0) E.hook(acc, cur, wr, wc, le & 15, le >> 4);
          else E(acc, cur, wr, wc, le & 15, le >> 4); }
        if (!has_next) break;
        if (seg == 1) ++ui;
        cur = nxt; cA = nA; cB = nB; hs = nhs; ck = nk; seg = nseg;
        if (wr == 1) PG8_BAR;
    }
    PG8_WAIT_V(0);
    PG8_BAR;
#undef PG8_SA
#undef PG8_SB
#undef PG8_STAGE2
#undef PG8_MMAZ
#undef PG8_LDA
#undef PG8_LDB
#undef PG8_MMA
#undef PG8_WAIT_V
#undef PG8_WAIT_L
#undef PG8_BAR
#undef PG8_SCHED
}
struct Gemm4 { const bf16_t* A[4]; const bf16_t* Bt[4]; int K[4]; int bpn[4]; };
template <class Epi, class Sched>
__device__ __forceinline__ void gemm_phase4(LAS unsigned char* lds, const Gemm4 g, const Sched& S, const Epi& E, int wid_s) {
    const int tid = tid_local(wid_s), wid = __builtin_amdgcn_readfirstlane(tid >> 6), lane = tid & 63, wr = wid >> 2, wc = wid & 3, fr = lane & 15, fq = lane >> 4;
    unsigned R2_, C2;
    { int R, C; stage_rc(tid * 16, R, C); R2_ = (unsigned)R * 2u; C2 = (unsigned)C * 2u; }
    const size_t kstep = (size_t)(BK * 2);
    const unsigned ldsw = (unsigned)wid * 1024u;
    const int aoff = lds_byte(wr * 64 + fr, fq * 8), boff = lds_byte(wc * 32 + fr, fq * 8);
#define PG8_SA(b, h) (((b) * 2 + (h)) * HTB)
#define PG8_SB(b, h) ((4 + (b) * 2 + (h)) * HTB)
#define PG8_STAGE2(bufoff, gbase, KK) do { const char* _gb = (const char*)(gbase); const unsigned _k = (unsigned)(KK); const unsigned _vo = R2 * _k + C2; \
        __builtin_amdgcn_global_load_lds((const unsigned*)(_gb + _vo), (LAS unsigned*)(lds + (bufoff) + ldsw), 16, 0, 0); \
        __builtin_amdgcn_global_load_lds((const unsigned*)(_gb + (size_t)128 * _k + _vo), (LAS unsigned*)(lds + (bufoff) + ldsw + 8192), 16, 0, 0); } while (0)
#define PG8_LDA(dst, b, h) do { _Pragma("unroll") for (int m = 0; m < 4; ++m) _Pragma("unroll") for (int k = 0; k < 2; ++k) dst[m][k] = *(const LAS bf16x8*)(lds + PG8_SA(b, h) + aoff + m * 2048 + k * 1024); } while (0)
#define PG8_LDB(dst, b, h) do { _Pragma("unroll") for (int n = 0; n < 2; ++n) _Pragma("unroll") for (int k = 0; k < 2; ++k) dst[n][k] = *(const LAS bf16x8*)(lds + PG8_SB(b, h) + boff + n * 2048 + k * 1024); } while (0)
#define PG8_MMA(ai, bj, At, Bt) do { __builtin_amdgcn_s_setprio(3); _Pragma("unroll") for (int m = 0; m < 4; ++m) _Pragma("unroll") for (int n = 0; n < 2; ++n) _Pragma("unroll") for (int k = 0; k < 2; ++k) \
        ac[ai][bj][m][n] = __builtin_amdgcn_mfma_f32_16x16x32_bf16(Bt[n][k], At[m][k], ac[ai][bj][m][n], 0, 0, 0); __builtin_amdgcn_s_setprio(0); } while (0)
#define PG8_MMAZ(ai, bj, At, Bt, FIRST) do { __builtin_amdgcn_s_setprio(3); \
        if (FIRST) { _Pragma("unroll") for (int m = 0; m < 4; ++m) _Pragma("unroll") for (int n = 0; n < 2; ++n) ac[ai][bj][m][n] = __builtin_amdgcn_mfma_f32_16x16x32_bf16(Bt[n][0], At[m][0], (f32x4){0.f, 0.f, 0.f, 0.f}, 0, 0, 0); } \
        else { _Pragma("unroll") for (int m = 0; m < 4; ++m) _Pragma("unroll") for (int n = 0; n < 2; ++n) ac[ai][bj][m][n] = __builtin_amdgcn_mfma_f32_16x16x32_bf16(Bt[n][0], At[m][0], ac[ai][bj][m][n], 0, 0, 0); } \
        _Pragma("unroll") for (int m = 0; m < 4; ++m) _Pragma("unroll") for (int n = 0; n < 2; ++n) ac[ai][bj][m][n] = __builtin_amdgcn_mfma_f32_16x16x32_bf16(Bt[n][1], At[m][1], ac[ai][bj][m][n], 0, 0, 0); \
        __builtin_amdgcn_s_setprio(0); } while (0)
#define PG8_WAIT_V(n) asm volatile("s_waitcnt vmcnt(" #n ")" ::: "memory")
#define PG8_WAIT_L(n) asm volatile("s_waitcnt lgkmcnt(0)" ::: "memory")
#define PG8_BAR __builtin_amdgcn_s_barrier()
#define PG8_SCHED __builtin_amdgcn_sched_barrier(0)
    Unit cur, nxt;
    if (!S.next(0, cur)) return;
    bf16x8 At[4][2], B0[2][2], B1[2][2];
    auto kloop = [&](f32x4 (&ac)[2][2][4][2], const char* cA, const char* cB, int ck, const char* nA, const char* nB, int nk, const bool FRESH) __attribute__((always_inline)) {
        const size_t hs = (size_t)HALF * ck * 2, nhs = (size_t)HALF * nk * 2; const int nt = ck / BK;
        unsigned R2 = R2_; asm volatile("" : "+v"(R2));
        for (int t = 0; t < nt; t += 2) {
            const bool last = (t == nt - 2);
            const char* a1 = cA + (size_t)(t + 1) * kstep;
            const char* a2 = last ? nA : cA + (size_t)(t + 2) * kstep; const char* b2 = last ? nB : cB + (size_t)(t + 2) * kstep;
            const char* a3 = a2 + kstep; const char* b3 = b2 + kstep;
            const size_t h2 = last ? nhs : hs; const int wk = last ? nk : ck;
            const bool fresh = FRESH && (t == 0);
            PG8_LDB(B0, 0, 0); PG8_LDB(B1, 0, 1); PG8_SCHED; PG8_LDA(At, 0, 0); PG8_STAGE2(PG8_SA(1, 1), a1 + hs, ck);
            PG8_WAIT_V(8); PG8_WAIT_L(0); PG8_BAR; PG8_MMAZ(0, 0, At, B0, fresh); PG8_MMAZ(0, 1, At, B1, fresh); PG8_BAR; PG8_SCHED;
            PG8_LDA(At, 0, 1); PG8_STAGE2(PG8_SB(0, 0), b2, wk); PG8_STAGE2(PG8_SB(0, 1), b2 + h2, wk); PG8_STAGE2(PG8_SA(0, 0), a2, wk);
            PG8_WAIT_V(8); PG8_WAIT_L(0); PG8_BAR; PG8_MMAZ(1, 0, At, B0, fresh); PG8_MMAZ(1, 1, At, B1, fresh); PG8_BAR; PG8_SCHED;
            PG8_LDB(B0, 1, 0); PG8_LDB(B1, 1, 1); PG8_SCHED; PG8_LDA(At, 1, 0); PG8_STAGE2(PG8_SA(0, 1), a2 + h2, wk);
            PG8_WAIT_V(8); PG8_WAIT_L(0); PG8_BAR; PG8_MMA(0, 0, At, B0); PG8_MMA(0, 1, At, B1); PG8_BAR; PG8_SCHED;
            PG8_LDA(At, 1, 1); PG8_STAGE2(PG8_SB(1, 0), b3, wk); PG8_STAGE2(PG8_SB(1, 1), b3 + h2, wk); PG8_STAGE2(PG8_SA(1, 0), a3, wk);
            PG8_WAIT_V(8); PG8_WAIT_L(0); PG8_BAR; PG8_MMA(1, 0, At, B0); PG8_MMA(1, 1, At, B1); PG8_BAR; PG8_SCHED;
        } };
    auto segA = [&](int sg, const Unit& u) __attribute__((always_inline)) -> const char* { const char* q = (const char*)g.A[sg] + (size_t)u.pm * 2 * ((size_t)HALF * g.K[sg] * 2); asm volatile("" : "+s"(q)); return q; };
    auto segB = [&](int sg, const Unit& u) __attribute__((always_inline)) -> const char* { const char* q = (const char*)g.Bt[sg] + (size_t)(u.pn + g.bpn[sg]) * 2 * ((size_t)HALF * g.K[sg] * 2); asm volatile("" : "+s"(q)); return q; };
    { const char* cA = segA(0, cur); const char* cB = segB(0, cur); const int ck = g.K[0]; const size_t hs = (size_t)HALF * ck * 2; const unsigned R2 = R2_;
      PG8_STAGE2(PG8_SB(0, 0), cB, ck); PG8_STAGE2(PG8_SB(0, 1), cB + hs, ck); PG8_STAGE2(PG8_SA(0, 0), cA, ck); PG8_STAGE2(PG8_SA(0, 1), cA + hs, ck);
      if (wr == 1) PG8_BAR;
      PG8_WAIT_V(2); PG8_BAR;
      PG8_STAGE2(PG8_SB(1, 0), cB + kstep, ck); PG8_STAGE2(PG8_SA(1, 0), cA + kstep, ck); PG8_STAGE2(PG8_SB(1, 1), cB + hs + kstep, ck);
      PG8_WAIT_V(6); PG8_BAR; }
    for (int ui = 0;; ++ui) {
        const bool has_next = S.next(ui + 1, nxt);
        int upm = cur.pm, upn = cur.pn; asm volatile("" : "+s"(upm), "+s"(upn));
        const Unit cu{upm, upn};
        {   f32x4 accg[2][2][4][2];
            kloop(accg, segA(0, cur), segB(0, cur), g.K[0], segA(1, cur), segB(1, cur), g.K[1], true);
            if (wr == 0) PG8_BAR;
            { const int le = lane_fresh(); E.es.template run<true>(accg, cu.pm, cu.pn, wr, wc, le & 15, le >> 4); }
            if (wr == 1) PG8_BAR;
            kloop(accg, segA(1, cur), segB(1, cur), g.K[1], segA(2, cur), segB(2, cur), g.K[2], true);
            if (wr == 0) PG8_BAR;
            { const int le = lane_fresh(); E.es.template run<false>(accg, cu.pm, cu.pn, wr, wc, le & 15, le >> 4); }
            if (wr == 1) PG8_BAR; }
        {   f32x4 acc[2][2][4][2];
            kloop(acc, segA(2, cur), segB(2, cur), g.K[2], segA(3, cur), segB(3, cur), g.K[3], true);
            if (wr == 0) PG8_BAR;
            { const int le = lane_fresh(); E.ey.hook(acc, cu, wr, wc, le & 15, le >> 4); }
            if (wr == 1) PG8_BAR;
            kloop(acc, segA(3, cur), segB(3, cur), g.K[3], has_next ? segA(0, nxt) : segA(3, cur), has_next ? segB(0, nxt) : segB(3, cur), has_next ? g.K[0] : g.K[3], false);
            if (wr == 0) PG8_BAR;
            { const int le = lane_fresh(); E.ey(acc, cu, wr, wc, le & 15, le >> 4); } }
        if (!has_next) break;
        cur = nxt;
        if (wr == 1) PG8_BAR;
    }
    PG8_WAIT_V(0);
    PG8_BAR;
#undef PG8_SA
#undef PG8_SB
#undef PG8_STAGE2
#undef PG8_MMAZ
#undef PG8_LDA
#undef PG8_LDB
#undef PG8_MMA
#undef PG8_WAIT_V
#undef PG8_WAIT_L
#undef PG8_BAR
#undef PG8_SCHED
}
}

#define LDS_WAIT() asm volatile("s_waitcnt lgkmcnt(0)" ::: "memory")
__device__ __forceinline__ float bf2f(unsigned b) { return __uint_as_float(b << 16); }
__device__ __forceinline__ unsigned f2bf(float f) { unsigned u = __float_as_uint(f); return (u + 0x7fffu + ((u >> 16) & 1u)) >> 16; }
__device__ __forceinline__ unsigned pk2(float lo, float hi) { return f2bf(lo) | (f2bf(hi) << 16); }
__device__ __forceinline__ float fast_exp2(float x) { return __builtin_amdgcn_exp2f(x); }
__device__ __forceinline__ float fast_rcp(float x) { return __builtin_amdgcn_rcpf(x); }
__device__ __forceinline__ float sigmoidf_(float x) { return fast_rcp(1.0f + fast_exp2(-LOG2E * x)); }
__device__ __forceinline__ float siluf_(float x) { return x * sigmoidf_(x); }
__device__ __forceinline__ float h2f(unsigned short h) { return (float)__builtin_bit_cast(_Float16, h); }
__device__ __forceinline__ unsigned pkh2(float lo, float hi) { return (unsigned)__builtin_bit_cast(unsigned short, (_Float16)lo) | ((unsigned)__builtin_bit_cast(unsigned short, (_Float16)hi) << 16); }
__device__ __forceinline__ float shflx(float v, int mask, int lane) { return __builtin_bit_cast(float, __builtin_amdgcn_ds_bpermute((lane ^ mask) << 2, __builtin_bit_cast(int, v))); }
__device__ __forceinline__ float shfl_from(float v, int src, int) { return __builtin_bit_cast(float, __builtin_amdgcn_ds_bpermute(src << 2, __builtin_bit_cast(int, v))); }
__device__ __forceinline__ float wave_sum(float v, int lane) {
#pragma unroll
    for (int o = 1; o < 64; o <<= 1) v += shflx(v, o, lane);
    return v;
}
__host__ __device__ __forceinline__ int perm_pos_std(int o) { const int e = o & 3, n = (o >> 2) & 1, fq = (o >> 3) & 3, wc = (o >> 5) & 3, bj = (o >> 7) & 1; return (bj << 7) | (wc << 5) | (n << 4) | (fq << 2) | e; }
__host__ __device__ __forceinline__ int perm_pos_att(int o) { const int e = o & 3, n = (o >> 2) & 1, fq = (o >> 3) & 3, bj = (o >> 5) & 1, wc = (o >> 6) & 3; return (bj << 7) | (wc << 5) | (n << 4) | (fq << 2) | e; }
__device__ __forceinline__ int t5_bucket(int rel) {
    const int n = rel < 0 ? -rel : rel;
    int v = n < 8 ? n : (n <= 14 ? 8 : (n <= 26 ? 9 : (n <= 49 ? 10 : (n <= 90 ? 11 : (n <= 165 ? 12 : (n <= 304 ? 13 : (n <= 558 ? 14 : 15)))))));
    return (rel > 0 ? 16 : 0) + v;
}

struct Args {
    const float* x; const float* norm_w; const float* w_in; const float* q_norm_w; const float* k_norm_w; const float* rel_bias;
    const float* lb_fwd; const float* lb_bwd; const float* hg_norm_w; const float* w_proj_a; const float* w_proj_b; const float* w_out;
    float* out; unsigned char* ws;
};

template <int KIND>
__device__ __forceinline__ void p0_transpose_item(const float* W, int K, int N, bf16_t* WT, LAS float* scr, int item, int lane) {
    const int nblk = N / 32, kb = item / nblk, nb = item % nblk, k0 = 64 * kb, n0 = 32 * nb;
#pragma unroll 8
    for (int i = 0; i < 32; ++i) { const int kk = 2 * i + (lane >> 5); scr[kk * 33 + (lane & 31)] = W[(size_t)(k0 + kk) * N + n0 + (lane & 31)]; }
    LDS_WAIT(); asm volatile("" ::: "memory");
    const int c = lane & 7;
#pragma unroll
    for (int j = 0; j < 4; ++j) { const int n = (lane >> 3) + 8 * j; const LAS float* s = scr + (8 * c) * 33 + n;
        u32x4 o; o.x = pk2(s[0 * 33], s[1 * 33]); o.y = pk2(s[2 * 33], s[3 * 33]); o.z = pk2(s[4 * 33], s[5 * 33]); o.w = pk2(s[6 * 33], s[7 * 33]);
        const int col = n0 + n, tile = col >> 8, loc = col & 255;
        const int pos = (KIND == 1 && tile < 18) ? perm_pos_att(loc) : perm_pos_std(loc);
        *(u32x4*)(WT + (size_t)(tile * 256 + pos) * K + k0 + 8 * c) = o; }
    LDS_WAIT(); asm volatile("" ::: "memory");
}
__device__ __forceinline__ void p0_prologue(const Args& a, LAS unsigned char* lds, int vcu, int G, int wid_s) {
    const int tidl = tid_local(wid_s), lane = tidl & 63, wave = tidl >> 6;
    LAS float* scr = (LAS float*)(lds + wave * 16384);
    const int gw = vcu * NWAVES + wave, NGW = G * NWAVES;
    constexpr int I_IN = (1024 / 64) * (INCOLS / 32), I_A = (512 / 64) * (1024 / 32), I_B = (1024 / 64) * (1024 / 32), I_O = I_B;
    constexpr int NITEMS = I_IN + I_A + I_B + I_O;
    bf16_t* wtin = (bf16_t*)(a.ws + WS_WIN); bf16_t* wta = (bf16_t*)(a.ws + WS_WA); bf16_t* wtb = (bf16_t*)(a.ws + WS_WB); bf16_t* wto = (bf16_t*)(a.ws + WS_WO);
    for (int it = gw; it < NITEMS; it += NGW) {
        int r = it;
        if (r < I_IN) { p0_transpose_item<1>(a.w_in, 1024, INCOLS, wtin, scr, r, lane); continue; } r -= I_IN;
        if (r < I_A) { p0_transpose_item<0>(a.w_proj_a, 512, 1024, wta, scr, r, lane); continue; } r -= I_A;
        if (r < I_B) { p0_transpose_item<0>(a.w_proj_b, 1024, 1024, wtb, scr, r, lane); continue; } r -= I_B;
        p0_transpose_item<0>(a.w_out, 1024, 1024, wto, scr, r, lane);
    }
    bf16_t* H = (bf16_t*)(a.ws + WS_H);
    f32x4 w[4];
#pragma unroll
    for (int j = 0; j < 4; ++j) w[j] = ((const f32x4*)a.norm_w)[64 * j + lane];
    for (int m = gw; m < MTOK; m += NGW) {
        const f32x4* xr = (const f32x4*)(a.x + (size_t)m * DM) + lane;
        f32x4 v[4]; float s = 0.f;
#pragma unroll
        for (int j = 0; j < 4; ++j) { v[j] = xr[64 * j]; s += (v[j].x * v[j].x + v[j].y * v[j].y) + (v[j].z * v[j].z + v[j].w * v[j].w); }
        const float rstd = __builtin_amdgcn_rsqf(wave_sum(s, lane) * (1.f / DM) + 1e-6f);
        u32x2* o8 = (u32x2*)(H + (size_t)m * DM) + lane;
#pragma unroll
        for (int j = 0; j < 4; ++j) { u32x2 o; o.x = pk2(v[j].x * rstd * w[j].x, v[j].y * rstd * w[j].y); o.y = pk2(v[j].z * rstd * w[j].z, v[j].w * rstd * w[j].w); o8[64 * j] = o; }
    }
}

struct EpiIn {
    static constexpr bool PERM = false, AFTER_DRAIN = false;
    int pn0; unsigned char* wsb; bf16_t* qkv; bf16_t* zg; const float* qnw; const float* knw; const float* lbf; const float* lbb;
    template <bool NORM> __device__ __forceinline__ void att_tile(const f32x4 (&acc)[2][2][4][2], int row0, int g, int t, int h, int fr, int fq, const float* nw, float sc) const {
        const int sh = 2 * g;
        f32x4 wv[2][2];
        if (NORM) {
#pragma unroll
            for (int bj = 0; bj < 2; ++bj)
#pragma unroll
                for (int n = 0; n < 2; ++n) wv[bj][n] = *(const f32x4*)(nw + g * 64 + 8 * fq + 32 * bj + 4 * n) * sc; }
        bf16_t* tb = qkv + ((size_t)(((g * 3 + t) * 8) * 8 + h)) * 4096 * 64 + 8 * fq;
        float rs[2][4];
        if (NORM) {
#pragma unroll
            for (int ai = 0; ai < 2; ++ai)
#pragma unroll
                for (int m = 0; m < 4; ++m) { float ss = 0.f;
#pragma unroll
                    for (int bj = 0; bj < 2; ++bj)
#pragma unroll
                        for (int n = 0; n < 2; ++n) { const f32x4 v = acc[ai][bj][m][n]; ss += (v.x * v.x + v.y * v.y) + (v.z * v.z + v.w * v.w); }
                    rs[ai][m] = ss; }
            const int l16 = ((fq * 16 + fr) ^ 16) << 2, l32 = ((fq * 16 + fr) ^ 32) << 2;
#pragma unroll
            for (int ai = 0; ai < 2; ++ai)
#pragma unroll
                for (int m = 0; m < 4; ++m) rs[ai][m] += __builtin_bit_cast(float, __builtin_amdgcn_ds_bpermute(l16, __builtin_bit_cast(int, rs[ai][m])));
#pragma unroll
            for (int ai = 0; ai < 2; ++ai)
#pragma unroll
                for (int m = 0; m < 4; ++m) rs[ai][m] += __builtin_bit_cast(float, __builtin_amdgcn_ds_bpermute(l32, __builtin_bit_cast(int, rs[ai][m])));
#pragma unroll
            for (int ai = 0; ai < 2; ++ai)
#pragma unroll
                for (int m = 0; m < 4; ++m) rs[ai][m] = __builtin_amdgcn_rsqf(rs[ai][m] * (1.f / 64.f) + 1e-6f);
        }
#pragma unroll
        for (int ai = 0; ai < 2; ++ai)
#pragma unroll
            for (int m = 0; m < 4; ++m) {
                const int r = row0 + ai * 128 + m * 16, b = r >> 12, s = r & 4095;
                const int rowp = (s & ((1 << sh) - 1)) * (4096 >> sh) + (s >> sh);
                f32x4 v[2][2];
#pragma unroll
                for (int bj = 0; bj < 2; ++bj)
#pragma unroll
                    for (int n = 0; n < 2; ++n) { v[bj][n] = acc[ai][bj][m][n]; if (NORM) v[bj][n] = v[bj][n] * rs[ai][m] * wv[bj][n]; }
                bf16_t* dst = tb + ((size_t)(b * 8) * 4096 + rowp) * 64;
#pragma unroll
                for (int bj = 0; bj < 2; ++bj) { u32x4 w; w.x = pg8::cvt_pk_bf16(v[bj][0].x, v[bj][0].y); w.y = pg8::cvt_pk_bf16(v[bj][0].z, v[bj][0].w); w.z = pg8::cvt_pk_bf16(v[bj][1].x, v[bj][1].y); w.w = pg8::cvt_pk_bf16(v[bj][1].z, v[bj][1].w);
                    __builtin_nontemporal_store(w, (u32x4*)(dst + 32 * bj)); }
                __builtin_amdgcn_sched_barrier(0);
            }
    }
    template <int ACT, int LAY> __device__ __forceinline__ void ew_tile(const f32x4 (&acc)[2][2][4][2], int row0, int ct, int wc, int fq, bf16_t* base, int ldc, const float* lbp) const {
        f32x4 l0[2], l1[2];
        if (ACT == 3) {
#pragma unroll
            for (int bj = 0; bj < 2; ++bj) { const float* lp = lbp + (ct & 3) * 256 + bj * 128 + wc * 32 + 8 * fq;
                const f32x4 a00 = *(const f32x4*)lp, a01 = *(const f32x4*)(lp + 4), a10 = *(const f32x4*)(lp + 1024), a11 = *(const f32x4*)(lp + 1028);
#pragma unroll
                for (int j = 0; j < 4; ++j) { l0[bj][j] = fast_rcp(1.0f + fast_exp2(LOG2E * (a10[j] - a00[j]))); l1[bj][j] = fast_rcp(1.0f + fast_exp2(LOG2E * (a11[j] - a01[j]))); } } }
#pragma unroll
        for (int ai = 0; ai < 2; ++ai)
#pragma unroll
            for (int m = 0; m < 4; ++m) { const int rr = row0 + ai * 128 + m * 16;
                bf16_t* rowp;
                if (LAY == 0) rowp = base + (size_t)rr * ldc + ct * 256 + wc * 32 + 8 * fq;
                else if (LAY == 1) rowp = base + ((size_t)((((rr >> 12) * 8 + 2 * (ct & 3)) * 128 + ((rr & 4095) >> 5)) * 4 + (ct >> 2)) * 32 + (rr & 31)) * 128 + wc * 32 + 8 * fq;
                else rowp = base + ((size_t)(((((rr >> 12) * 8 + 2 * ct) * 128 + ((rr & 4095) >> 5)) * 4 + wc) * 4 + fq) * 64 + (rr & 31)) * 4;
#pragma unroll
                for (int bj = 0; bj < 2; ++bj) { f32x4 v0 = acc[ai][bj][m][0], v1 = acc[ai][bj][m][1];
                    u32x4 w;
                    if (ACT == 3) {
#pragma unroll
                        for (int j = 0; j < 4; ++j) { v0[j] = __builtin_amdgcn_logf(l0[bj][j] + (1.0f - l0[bj][j]) * sigmoidf_(v0[j])); v1[j] = __builtin_amdgcn_logf(l1[bj][j] + (1.0f - l1[bj][j]) * sigmoidf_(v1[j])); }
                        w.x = pkh2(v0.x, v0.y); w.y = pkh2(v0.z, v0.w); w.z = pkh2(v1.x, v1.y); w.w = pkh2(v1.z, v1.w);
                    } else {
                        if (ACT == 1) {
#pragma unroll
                            for (int j = 0; j < 4; ++j) { v0[j] = siluf_(v0[j]); v1[j] = siluf_(v1[j]); } }
                        w.x = pg8::cvt_pk_bf16(v0.x, v0.y); w.y = pg8::cvt_pk_bf16(v0.z, v0.w); w.z = pg8::cvt_pk_bf16(v1.x, v1.y); w.w = pg8::cvt_pk_bf16(v1.z, v1.w);
                    }
                    if (LAY == 2) { bf16_t* gp = rowp + (size_t)bj * (128 * 4 * 4 * 64 * 4);
                        __builtin_nontemporal_store((u32x2){w.x, w.y}, (u32x2*)gp); __builtin_nontemporal_store((u32x2){w.z, w.w}, (u32x2*)(gp + 32 * 4)); }
                    else __builtin_nontemporal_store(w, (u32x4*)(rowp + (LAY == 1 ? bj * (128 * 4 * 4096) : bj * 128))); }
                __builtin_amdgcn_sched_barrier(0); }
    }
    __device__ __forceinline__ void operator()(const f32x4 (&acc)[2][2][4][2], const pg8::Unit& u, int wr, int wc, int fr, int fq) const {
        const int T = __builtin_amdgcn_readfirstlane(pn0 + u.pn);
        const int row0 = __builtin_amdgcn_readfirstlane(u.pm) * 256 + wr * 64 + fr;
        if (T < 18) {
            const int g = T / 6, t = (T % 6) >> 1, h = ((T & 1) << 2) + wc;
            if (t == 0) att_tile<true>(acc, row0, g, 0, h, fr, fq, qnw, 0.125f * LOG2E);
            else if (t == 1) att_tile<true>(acc, row0, g, 1, h, fr, fq, knw, 1.0f);
            else att_tile<false>(acc, row0, g, 2, h, fr, fq, nullptr, 1.0f);
        }
        else if (T < 20) ew_tile<1, 0>(acc, row0, T - 18, wc, fq, (bf16_t*)(wsb + WS_GA), 512, nullptr);
        else if (T < 24) ew_tile<0, 1>(acc, row0, T - 20, wc, fq, (bf16_t*)(wsb + WS_HG), 0, nullptr);
        else if (T < 28) ew_tile<3, 1>(acc, row0, T - 20, wc, fq, (bf16_t*)(wsb + WS_HG), 0, lbf);
        else if (T < 32) ew_tile<3, 1>(acc, row0, T - 20, wc, fq, (bf16_t*)(wsb + WS_HG), 0, lbb);
        else if (T < 36) ew_tile<0, 1>(acc, row0, T - 20, wc, fq, (bf16_t*)(wsb + WS_HG), 0, nullptr);
        else ew_tile<1, 2>(acc, row0, T - 36, wc, fq, (bf16_t*)(wsb + WS_GB), 0, nullptr);
    }
};
struct EpiSig {
    static constexpr bool PERM = false, AFTER_DRAIN = false;
    bf16_t* t; bf16_t* t2;
    __device__ __forceinline__ void operator()(const f32x4 (&acc)[2][2][4][2], const pg8::Unit& u, int wr, int wc, int fr, int fq) const {
        const int pnu = __builtin_amdgcn_readfirstlane(u.pn);
        if (pnu >= 4) run<true>(acc, u.pm, pnu & 3, wr, wc, fr, fq); else run<false>(acc, u.pm, pnu, wr, wc, fr, fq); }
    template <bool isb> __device__ __forceinline__ void run(const f32x4 (&acc)[2][2][4][2], int upm, int pn4, int wr, int wc, int fr, int fq) const {
        const int row0 = upm * 256 + wr * 64 + fr, col0 = pn4 * 256 + wc * 32 + 8 * fq;
#pragma unroll
        for (int ai = 0; ai < 2; ++ai)
#pragma unroll
          for (int mp = 0; mp < 4; mp += 2) {
            u32x4 bz[2][2];
            if (!isb) {
#pragma unroll
                for (int mm = 0; mm < 2; ++mm)
#pragma unroll
                    for (int bj = 0; bj < 2; ++bj) bz[mm][bj] = *(const u32x4*)(t2 + (size_t)(row0 + ai * 128 + (mp + mm) * 16) * 1024 + col0 + bj * 128);
                asm volatile("" ::: "memory"); }
#pragma unroll
            for (int mm = 0; mm < 2; ++mm) { const int m = mp + mm; const size_t ro = (size_t)(row0 + ai * 128 + m * 16) * 1024 + col0;
#pragma unroll
                for (int bj = 0; bj < 2; ++bj) { const f32x4 v0 = acc[ai][bj][m][0], v1 = acc[ai][bj][m][1];
                    float o[8] = {sigmoidf_(v0.x), sigmoidf_(v0.y), sigmoidf_(v0.z), sigmoidf_(v0.w), sigmoidf_(v1.x), sigmoidf_(v1.y), sigmoidf_(v1.z), sigmoidf_(v1.w)};
                    if (!isb) { const u32x4 b4 = bz[mm][bj];
                        o[0] *= fast_rcp(bf2f(b4.x & 0xffffu)); o[1] *= fast_rcp(bf2f(b4.x >> 16)); o[2] *= fast_rcp(bf2f(b4.y & 0xffffu)); o[3] *= fast_rcp(bf2f(b4.y >> 16));
                        o[4] *= fast_rcp(bf2f(b4.z & 0xffffu)); o[5] *= fast_rcp(bf2f(b4.z >> 16)); o[6] *= fast_rcp(bf2f(b4.w & 0xffffu)); o[7] *= fast_rcp(bf2f(b4.w >> 16)); }
                    u32x4 w; w.x = pg8::cvt_pk_bf16(o[0], o[1]); w.y = pg8::cvt_pk_bf16(o[2], o[3]); w.z = pg8::cvt_pk_bf16(o[4], o[5]); w.w = pg8::cvt_pk_bf16(o[6], o[7]);
                    *(u32x4*)((isb ? t2 : t) + ro + bj * 128) = w; } }
            asm volatile("" ::: "memory");
          }
    }
};
struct EpiY2 {
    static constexpr bool PERM = false, AFTER_DRAIN = false;
    const bf16_t* t; const bf16_t* t2; bf16_t* mg;
    __device__ __forceinline__ void hook(f32x4 (&acc)[2][2][4][2], const pg8::Unit& u, int wr, int wc, int fr, int fq) const {
        int upm = u.pm, upn = u.pn; asm volatile("" : "+s"(upm), "+s"(upn));
        const int row0 = upm * 256 + wr * 64 + fr, col0 = upn * 256 + wc * 32 + 8 * fq;
        u32x4 gz[2][4][2];
#pragma unroll
        for (int ai = 0; ai < 2; ++ai)
#pragma unroll
            for (int m = 0; m < 4; ++m)
#pragma unroll
                for (int bj = 0; bj < 2; ++bj) gz[ai][m][bj] = *(const u32x4*)(t + (size_t)(row0 + ai * 128 + m * 16) * 1024 + col0 + bj * 128);
        asm volatile("" ::: "memory");
#pragma unroll
        for (int ai = 0; ai < 2; ++ai)
#pragma unroll
            for (int m = 0; m < 4; ++m)
#pragma unroll
                for (int bj = 0; bj < 2; ++bj) { const u32x4 g4 = gz[ai][m][bj];
                    acc[ai][bj][m][0].x *= bf2f(g4.x & 0xffffu); acc[ai][bj][m][0].y *= bf2f(g4.x >> 16); acc[ai][bj][m][0].z *= bf2f(g4.y & 0xffffu); acc[ai][bj][m][0].w *= bf2f(g4.y >> 16);
                    acc[ai][bj][m][1].x *= bf2f(g4.z & 0xffffu); acc[ai][bj][m][1].y *= bf2f(g4.z >> 16); acc[ai][bj][m][1].z *= bf2f(g4.w & 0xffffu); acc[ai][bj][m][1].w *= bf2f(g4.w >> 16); }
    }
    __device__ __forceinline__ void operator()(const f32x4 (&acc)[2][2][4][2], const pg8::Unit& u, int wr, int wc, int fr, int fq) const {
        int upm = u.pm, upn = u.pn; asm volatile("" : "+s"(upm), "+s"(upn));
        const int row0 = upm * 256 + wr * 64 + fr, col0 = upn * 256 + wc * 32 + 8 * fq;
        u32x4 gz[2][4][2];
#pragma unroll
        for (int ai = 0; ai < 2; ++ai)
#pragma unroll
            for (int m = 0; m < 4; ++m)
#pragma unroll
                for (int bj = 0; bj < 2; ++bj) gz[ai][m][bj] = *(const u32x4*)(t2 + (size_t)(row0 + ai * 128 + m * 16) * 1024 + col0 + bj * 128);
        asm volatile("" ::: "memory");
#pragma unroll
        for (int ai = 0; ai < 2; ++ai)
#pragma unroll
            for (int m = 0; m < 4; ++m) {
#pragma unroll
                for (int bj = 0; bj < 2; ++bj) { const u32x4 g4 = gz[ai][m][bj]; const f32x4 v0 = acc[ai][bj][m][0], v1 = acc[ai][bj][m][1];
                    u32x4 w;
                    w.x = pg8::cvt_pk_bf16(v0.x * bf2f(g4.x & 0xffffu), v0.y * bf2f(g4.x >> 16)); w.y = pg8::cvt_pk_bf16(v0.z * bf2f(g4.y & 0xffffu), v0.w * bf2f(g4.y >> 16));
                    w.z = pg8::cvt_pk_bf16(v1.x * bf2f(g4.z & 0xffffu), v1.y * bf2f(g4.z >> 16)); w.w = pg8::cvt_pk_bf16(v1.z * bf2f(g4.w & 0xffffu), v1.w * bf2f(g4.w >> 16));
                    *(u32x4*)(mg + (size_t)(row0 + ai * 128 + m * 16) * 1024 + col0 + bj * 128) = w; }
                __builtin_amdgcn_sched_barrier(0); }
    }
};
struct EpiP3 { EpiSig es; EpiY2 ey; };
struct EpiOut {
    static constexpr bool PERM = false, AFTER_DRAIN = false;
    const float* x; float* out;
    __device__ __forceinline__ void operator()(f32x4 (&acc)[2][2][4][2], const pg8::Unit& u, int wr, int wc, int fr, int fq) const {
        const int row0 = u.pm * 256 + wr * 64 + fr, col0 = u.pn * 256 + wc * 32 + 8 * fq;
#pragma unroll
        for (int ai = 0; ai < 2; ++ai) {
            f32x4 xv[4][2][2];
#pragma unroll
            for (int m = 0; m < 4; ++m) { const size_t off = (size_t)(row0 + ai * 128 + m * 16) * 1024 + col0;
#pragma unroll
                for (int bj = 0; bj < 2; ++bj)
#pragma unroll
                    for (int n = 0; n < 2; ++n) xv[m][bj][n] = __builtin_nontemporal_load((const f32x4*)(x + off + bj * 128 + 4 * n)); }
#pragma unroll
            for (int m = 0; m < 4; ++m)
#pragma unroll
                for (int bj = 0; bj < 2; ++bj)
#pragma unroll
                    for (int n = 0; n < 2; ++n) acc[ai][bj][m][n] += xv[m][bj][n];
            asm volatile("" ::: "memory");
        }
#pragma unroll
        for (int ai = 0; ai < 2; ++ai)
#pragma unroll
            for (int m = 0; m < 4; ++m) { const size_t off = (size_t)(row0 + ai * 128 + m * 16) * 1024 + col0;
#pragma unroll
                for (int bj = 0; bj < 2; ++bj)
#pragma unroll
                    for (int n = 0; n < 2; ++n) __builtin_nontemporal_store(acc[ai][bj][m][n], (f32x4*)(out + off + bj * 128 + 4 * n)); }
    }
};

typedef float f32x16 __attribute__((ext_vector_type(16)));
typedef short s16x4 __attribute__((ext_vector_type(4)));
typedef __bf16 bf16x2_t __attribute__((ext_vector_type(2)));
__device__ __forceinline__ unsigned cvtpk(float lo, float hi) { f32x2 v = {lo, hi}; bf16x2_t b = __builtin_convertvector(v, bf16x2_t); return __builtin_bit_cast(unsigned, b); }
template <int S_> __device__ __forceinline__ bf16x8 pack_step(const f32x16& x) {
    u32x4 p; p.x = cvtpk(x[8 * S_ + 0], x[8 * S_ + 1]); p.y = cvtpk(x[8 * S_ + 2], x[8 * S_ + 3]); p.z = cvtpk(x[8 * S_ + 4], x[8 * S_ + 5]); p.w = cvtpk(x[8 * S_ + 6], x[8 * S_ + 7]);
    return __builtin_bit_cast(bf16x8, p);
}
__device__ __forceinline__ bf16x8 ld8x2(const LAS unsigned char* p0, const LAS unsigned char* p1) { const s16x4 lo = *(const LAS s16x4*)p0, hi = *(const LAS s16x4*)p1; return __builtin_shufflevector(lo, hi, 0, 1, 2, 3, 4, 5, 6, 7); }
#define MFMA32(a, b, c) __builtin_amdgcn_mfma_f32_32x32x16_bf16((a), (b), (c), 0, 0, 0)
namespace attn {
typedef short v4i16_t __attribute__((ext_vector_type(4)));
__device__ __forceinline__ s16x4 vtr(const LAS unsigned char* p) { return __builtin_bit_cast(s16x4, __builtin_amdgcn_ds_read_tr16_b64_v4i16((LAS v4i16_t*)p)); }
constexpr int TAB_BYTES = 3 * 8 * 192 * 4;
constexpr int V_P = 192, VT_BYTES = 32 * V_P;
constexpr int OFF_VST = TAB_BYTES, OFF_OB = OFF_VST + 8 * VT_BYTES, OB_P = 32  ;
constexpr int OFF_ML = OFF_OB + 512 * OB_P * 4, LDS_NEED = OFF_ML + 512 * 8;
static_assert(LDS_NEED <= LDS_XB_OFF, "attention LDS map");
__device__ __forceinline__ int osw(int t) { return (t ^ (t >> 1) ^ (t >> 4)) & 31; }
__device__ __forceinline__ void phase(const Args& a, LAS unsigned char* lds, int vcu, int wid_s) {
    const int tidl = tid_local(wid_s), wave = __builtin_amdgcn_readfirstlane(tidl >> 6), lane = tidl & 63, r32 = lane & 31, hh = lane >> 5;
    LAS float* tab = (LAS float*)lds;
    for (int e = tidl; e < 3 * 8 * 192; e += NTHREADS) { const int idx = e % 192, gh = e / 192, g = gh >> 3, rel = idx - 95;
        float v = 0.f; if (rel >= -64 && rel <= 64) v = a.rel_bias[t5_bucket(rel * (1 << (2 * g))) * 24 + gh] * LOG2E;
        tab[e] = v; }
    __syncthreads();
    LAS unsigned char* vl = lds + OFF_VST + wave * VT_BYTES;
    LAS unsigned* ob = (LAS unsigned*)(lds + OFF_OB); LAS f32x2* mlb = (LAS f32x2*)(lds + OFF_ML);
    const bf16_t* qkv = (const bf16_t*)(a.ws + WS_QKV);
    const int trq = (lane & 15) >> 2, trp = lane & 3, trblk = (lane >> 4) & 1;
    const LAS unsigned char* vtr0 = vl + (4 * hh + trq) * V_P + (16 * trblk + 4 * trp) * 2;
    struct Item { const bf16_t* Q; const bf16_t* K; const bf16_t* V; const LAS float* tgh; int ft, aidx, ntl, tstr, tofs, d0, d1, g, b, h, w; };
    auto item_info = [&](int n) -> Item {
        Item it; const int tk = n / 6, g = (n % 6) >> 1, qq = n & 1, task = vcu * 2 + tk, b = task >> 6, h = (task >> 3) & 7, w = task & 7, q = wave * 2 + qq, sh = 2 * g;
        it.g = g; it.b = b; it.h = h; it.w = w; it.ntl = 128 >> sh;
        int r;
        if (g == 0) { r = 0; it.aidx = 16 * w + q; it.tstr = 1; it.tofs = 32 * q; }
        else if (g == 1) { r = q >> 2; it.aidx = 4 * w + (q & 3); it.tstr = 4; it.tofs = 128 * (q & 3) + r; }
        else { r = q; it.aidx = w; it.tstr = 16; it.tofs = r; }
        it.ft = r * it.ntl + it.aidx;
        it.Q = qkv + ((size_t)((((g * 3 + 0) * 8 + b) * 8 + h)) * 4096) * 64;
        it.K = qkv + ((size_t)((((g * 3 + 1) * 8 + b) * 8 + h)) * 4096) * 64;
        it.V = qkv + ((size_t)((((g * 3 + 2) * 8 + b) * 8 + h)) * 4096) * 64;
        it.tgh = tab + (g * 8 + h) * 192;
        it.d0 = it.aidx >= 2 ? -2 : -it.aidx; it.d1 = (it.ntl - 1 - it.aidx) >= 2 ? 2 : (it.ntl - 1 - it.aidx);
        return it; };
    struct Unit2 { Item A, B; bool hasb; int X0, X1, A0, A1, B0, B1; };
    auto unit_info = [&](int u) -> Unit2 {
        Unit2 U; const int tk = u >> 2, j = u & 3;
        if (j < 2) { U.A = item_info((tk * 3 + j) * 2); U.B = item_info((tk * 3 + j) * 2 + 1); U.hasb = true; }
        else { U.A = item_info((tk * 3 + 2) * 2 + (j - 2)); U.B = U.A; U.hasb = false; }
        U.A0 = U.A.ft + U.A.d0; U.A1 = U.A.ft + U.A.d1; U.B0 = U.B.ft + U.B.d0; U.B1 = U.B.ft + U.B.d1;
        U.X0 = U.A0; U.X1 = U.hasb ? U.B1 : U.A1;
        return U; };
    bf16x8 qa[4], qb[4], kf[4]; u32x4 vr[4];
    auto loadk = [&](const bf16_t* Kp, int kt) __attribute__((always_inline)) {
        int ln = lane; asm volatile("" : "+v"(ln));
        const bf16_t* kp = Kp + ((size_t)(32 * kt) + (ln & 31)) * 64 + 8 * (ln >> 5);
#pragma unroll
        for (int s = 0; s < 4; ++s) kf[s] = *(const bf16x8*)(kp + 16 * s); };
    auto loadv = [&](const bf16_t* Vp, int kt) __attribute__((always_inline)) {
        int ln = lane; asm volatile("" : "+v"(ln));
        const bf16_t* vp = Vp + ((size_t)(32 * kt) + (ln >> 3)) * 64 + (ln & 7) * 8;
#pragma unroll
        for (int j = 0; j < 4; ++j) vr[j] = *(const u32x4*)(vp + (size_t)j * 8 * 64); };
    auto loadq = [&](bf16x8 (&q)[4], const Item& it) __attribute__((always_inline)) {
        int ln = lane; asm volatile("" : "+v"(ln));
        const bf16_t* qp = it.Q + ((size_t)(32 * it.ft) + (ln & 31)) * 64 + 8 * (ln >> 5);
#pragma unroll
        for (int s = 0; s < 4; ++s) q[s] = *(const bf16x8*)(qp + 16 * s); };
    Unit2 cur = unit_info(0);
    const bool down = (wave & 1) != 0;
    loadq(qa, cur.A); loadq(qb, cur.B); loadk(cur.A.K, down ? cur.X1 : cur.X0); loadv(cur.A.V, down ? cur.X1 : cur.X0);
    for (int u = 0; u < 8; ++u) {
        const Unit2 nxt = unit_info(u + 1 < 8 ? u + 1 : u);
        const int g = cur.A.g;
        f32x16 OA0, OA1, OB0, OB1;
#pragma unroll
        for (int i = 0; i < 16; ++i) { OA0[i] = 0.f; OA1[i] = 0.f; OB0[i] = 0.f; OB1[i] = 0.f; }
        float mA = 0.f, lA = 0.f, mB = 0.f, lB = 0.f;
        const int rr = r32 - 4 * hh;
        auto scores = [&](f32x16& st, const Item& it, const bf16x8 (&q)[4], int dl, float mref) __attribute__((always_inline)) {
            const LAS float* tl = it.tgh + (32 * dl + 95 - r32 + 4 * hh);
#pragma unroll
            for (int reg = 0; reg < 16; ++reg) st[reg] = tl[(reg & 3) + 8 * (reg >> 2)] - mref;
#pragma unroll
            for (int s = 0; s < 4; ++s) st = MFMA32(kf[s], q[s], st); };
        auto softmax = [&](f32x16& st, int dl, float& mrun, float& lrun, f32x16& O0, f32x16& O1) __attribute__((always_inline)) {
            float mx = -1e30f;
            if (dl == -2) {
#pragma unroll
                for (int reg = 0; reg < 16; ++reg) { const int jo = (reg & 3) + 8 * (reg >> 2); const float v = (jo >= rr) ? st[reg] : -1e30f; st[reg] = v; mx = fmaxf(mx, v); }
            } else if (dl == 2) {
#pragma unroll
                for (int reg = 0; reg < 16; ++reg) { const int jo = (reg & 3) + 8 * (reg >> 2); const float v = (jo <= rr) ? st[reg] : -1e30f; st[reg] = v; mx = fmaxf(mx, v); }
            } else {
#pragma unroll
                for (int reg = 0; reg < 16; ++reg) mx = fmaxf(mx, st[reg]);
            }
            mx = fmaxf(mx, shflx(mx, 32, lane));
            float ps = 0.f;
            if (__all(mx <= 6.0f)) {
#pragma unroll
                for (int reg = 0; reg < 16; ++reg) { const float pv = fast_exp2(st[reg]); st[reg] = pv; ps += pv; }
                lrun += ps;
            } else {
                const float mn = fmaxf(mx, 0.f), al = fast_exp2(-mn);
#pragma unroll
                for (int reg = 0; reg < 16; ++reg) { const float pv = fast_exp2(st[reg] - mn); st[reg] = pv; ps += pv; }
                lrun = lrun * al + ps; mrun += mn;
#pragma unroll
                for (int i = 0; i < 16; ++i) { O0[i] *= al; O1[i] *= al; }
            } };
        const int nk = cur.X1 - cur.X0;
        for (int i = 0; i <= nk; ++i) {
            const int kt = down ? cur.X1 - i : cur.X0 + i, ktn = down ? kt - 1 : kt + 1;
            const bool actA = kt <= cur.A1, actB = cur.hasb && kt >= cur.B0;
            const bool lastt = i == nk;
            const int dlA = kt - cur.A.ft, dlB = kt - cur.B.ft;
            f32x16 sA, sB;
            if (actA) scores(sA, cur.A, qa, dlA, mA);
            if (actB) scores(sB, cur.B, qb, dlB, mB);
            loadk(lastt ? nxt.A.K : cur.A.K, lastt ? (down ? nxt.X1 : nxt.X0) : ktn);
            if (lastt) { loadq(qa, nxt.A); if (nxt.hasb) loadq(qb, nxt.B); }
            if (actA) softmax(sA, dlA, mA, lA, OA0, OA1);
            if (actB) softmax(sB, dlB, mB, lB, OB0, OB1);
            { int ln = lane; asm volatile("" : "+v"(ln));
              LAS unsigned char* vw = vl + (ln >> 3) * V_P + (ln & 7) * 16;
#pragma unroll
              for (int j = 0; j < 4; ++j) *(LAS u32x4*)(vw + j * 8 * V_P) = vr[j]; }
            loadv(lastt ? nxt.A.V : cur.A.V, lastt ? (down ? nxt.X1 : nxt.X0) : ktn);
            const s16x4 a00 = vtr(vtr0), a01 = vtr(vtr0 + 8 * V_P), a10 = vtr(vtr0 + 16 * V_P), a11 = vtr(vtr0 + 24 * V_P);
            const s16x4 b00 = vtr(vtr0 + 64), b01 = vtr(vtr0 + 8 * V_P + 64), b10 = vtr(vtr0 + 16 * V_P + 64), b11 = vtr(vtr0 + 24 * V_P + 64);
            const bf16x8 va0 = __builtin_shufflevector(a00, a01, 0, 1, 2, 3, 4, 5, 6, 7), va1 = __builtin_shufflevector(a10, a11, 0, 1, 2, 3, 4, 5, 6, 7);
            const bf16x8 vb0 = __builtin_shufflevector(b00, b01, 0, 1, 2, 3, 4, 5, 6, 7), vb1 = __builtin_shufflevector(b10, b11, 0, 1, 2, 3, 4, 5, 6, 7);
            if (actA) { const bf16x8 p0 = pack_step<0>(sA), p1 = pack_step<1>(sA);
                OA0 = MFMA32(va0, p0, OA0); OA0 = MFMA32(va1, p1, OA0); OA1 = MFMA32(vb0, p0, OA1); OA1 = MFMA32(vb1, p1, OA1); }
            if (actB) { const bf16x8 p0 = pack_step<0>(sB), p1 = pack_step<1>(sB);
                OB0 = MFMA32(va0, p0, OB0); OB0 = MFMA32(va1, p1, OB0); OB1 = MFMA32(vb0, p0, OB1); OB1 = MFMA32(vb1, p1, OB1); }
        }
        auto merge = [&](const Item& it, const f32x16& O0, const f32x16& O1, float mrun, float lrun) __attribute__((always_inline)) {
            const float ltot = lrun + shflx(lrun, 32, lane);
            const int tloc = r32 * it.tstr + it.tofs;
            float sc0, sc1;
            if (g == 0) { sc0 = 0.f; sc1 = fast_rcp(ltot); if (hh == 0) mlb[tloc] = (f32x2){mrun, ltot}; }
            else { const f32x2 mlo = mlb[tloc]; const float Mn = fmaxf(mlo.x, mrun), wa = mlo.y * fast_exp2(mlo.x - Mn), wb = fast_exp2(mrun - Mn), Ln = wa + ltot * wb, inv = fast_rcp(Ln);
                sc0 = wa * inv; sc1 = wb * inv; if (hh == 0) mlb[tloc] = (f32x2){Mn, Ln}; }
            LAS unsigned* orow = ob + tloc * OB_P; const int fs = osw(tloc), hx = 2 * hh;
#define OBW(k) orow[((k) + hx) ^ fs]
#pragma unroll
            for (int c = 0; c < 4; ++c) {
                float v0[4], v1[4];
#pragma unroll
                for (int e = 0; e < 4; ++e) { v0[e] = O0[4 * c + e] * sc1; v1[e] = O1[4 * c + e] * sc1; }
                if (g != 0) { const unsigned a0 = OBW(4 * c), a1 = OBW(4 * c + 1), b0 = OBW(16 + 4 * c), b1 = OBW(16 + 4 * c + 1);
                    v0[0] += sc0 * bf2f(a0 & 0xffffu); v0[1] += sc0 * bf2f(a0 >> 16); v0[2] += sc0 * bf2f(a1 & 0xffffu); v0[3] += sc0 * bf2f(a1 >> 16);
                    v1[0] += sc0 * bf2f(b0 & 0xffffu); v1[1] += sc0 * bf2f(b0 >> 16); v1[2] += sc0 * bf2f(b1 & 0xffffu); v1[3] += sc0 * bf2f(b1 >> 16); }
                OBW(4 * c) = cvtpk(v0[0], v0[1]); OBW(4 * c + 1) = cvtpk(v0[2], v0[3]); OBW(16 + 4 * c) = cvtpk(v1[0], v1[1]); OBW(16 + 4 * c + 1) = cvtpk(v1[2], v1[3]);
            }
#undef OBW
        };
        merge(cur.A, OA0, OA1, mA, lA);
        if (cur.hasb) merge(cur.B, OB0, OB1, mB, lB);
        if ((u & 3) != 2) {
            __syncthreads();
            if (g == 2) {
                const int tid2 = tid_local(wid_s);
#pragma unroll 1
                for (int j = 0; j < 8; ++j) {
                    const int tl_ = (tid2 >> 3) + 64 * j, c = tid2 & 7;
                    const size_t tok = (size_t)cur.A.b * 4096 + 512 * cur.A.w + tl_;
                    const u32x4 gv = *(const u32x4*)((const bf16_t*)(a.ws + WS_GA) + tok * 512 + cur.A.h * 64 + 8 * c);
                    const LAS unsigned* orw = ob + tl_ * OB_P; const int fs2 = osw(tl_);
                    const unsigned o0 = orw[(4 * c) ^ fs2], o1 = orw[(4 * c + 1) ^ fs2], o2 = orw[(4 * c + 2) ^ fs2], o3 = orw[(4 * c + 3) ^ fs2];
                    u32x4 wv4;
                    wv4.x = cvtpk(bf2f(o0 & 0xffffu) * bf2f(gv.x & 0xffffu), bf2f(o0 >> 16) * bf2f(gv.x >> 16)); wv4.y = cvtpk(bf2f(o1 & 0xffffu) * bf2f(gv.y & 0xffffu), bf2f(o1 >> 16) * bf2f(gv.y >> 16));
                    wv4.z = cvtpk(bf2f(o2 & 0xffffu) * bf2f(gv.z & 0xffffu), bf2f(o2 >> 16) * bf2f(gv.z >> 16)); wv4.w = cvtpk(bf2f(o3 & 0xffffu) * bf2f(gv.w & 0xffffu), bf2f(o3 >> 16) * bf2f(gv.w >> 16));
                    *(u32x4*)((bf16_t*)(a.ws + WS_A1) + tok * 512 + cur.A.h * 64 + 8 * c) = wv4; }
                __syncthreads();
            }
        }
        cur = nxt;
    }
}
}

namespace scan {
constexpr int QT_P = 272, KS_P = 80;
constexpr int OFF_QT = 0, OFF_KT = 8704, OFF_KST = 17408, OFF_VT = 27648, OFF_DEC = 37888, OPB_BYTES = 38400;
constexpr int RAW_GP = 1056;
constexpr int RZ = 0, RV = 8 * RAW_GP, RQ = 16 * RAW_GP;
constexpr int OFF_OPB = 0, OFF_RED = 2 * OPB_BYTES, OFF_RAW = OFF_RED + 512;
constexpr size_t ST_BYTES = 64 * MiB;
constexpr size_t WS_DL = 30 * MiB;
constexpr int OFF_PT = OFF_RAW + 2 * 24 * RAW_GP, PT_P = 72, PT_BYTES = 32 * PT_P, OFF_PCNT = OFF_PT + 2 * PT_BYTES;
constexpr int OFF_STG = OFF_RAW + 3 * 24 * RAW_GP, STG_P = 80;
#define SC_WAITV(n) asm volatile("s_waitcnt vmcnt(" #n ")" ::: "memory")
#define SC_BAR() do { asm volatile("s_waitcnt lgkmcnt(0)" ::: "memory"); __builtin_amdgcn_s_barrier(); asm volatile("" ::: "memory"); } while (0)
template <bool FULL, int DIR> __device__ __forceinline__ void issue_raw(LAS unsigned char* rawb, const bf16_t* hgc  , int w4, int lane) {
#pragma unroll
    for (int i = 0; i < 2; ++i) { const int grp = 2 * w4 + i; const bf16_t* src = hgc + grp * 512 + lane * 8;
        if (FULL) __builtin_amdgcn_global_load_lds((const unsigned*)src, (LAS unsigned*)(rawb + RQ + grp * RAW_GP), 16, 0, 0);
        __builtin_amdgcn_global_load_lds((const unsigned*)(src + 4096 * (1 + DIR)), (LAS unsigned*)(rawb + RZ + grp * RAW_GP), 16, 0, 0);
        __builtin_amdgcn_global_load_lds((const unsigned*)(src + 3 * 4096), (LAS unsigned*)(rawb + RV + grp * RAW_GP), 16, 0, 0); }
}
template <int NI> __device__ __forceinline__ void wait_younger(int y) {
    if (y <= 0) SC_WAITV(0);
    else if (y == 1) { if (NI == 6) SC_WAITV(6); else SC_WAITV(4); }
    else if (y == 2) { if (NI == 6) SC_WAITV(12); else SC_WAITV(8); }
    else { if (NI == 6) SC_WAITV(18); else SC_WAITV(12); }
}
template <bool FULL, int DIR> __device__ __forceinline__ void elem(LAS unsigned char* opb, const LAS unsigned char* rawb, int col0, int tq, int lane, float& gsum0, float& gsum1) {
    unsigned rq[8], rz[8];
#pragma unroll
    for (int t = 0; t < 8; ++t) { const int o = (2 * tq + (t >> 2)) * RAW_GP + (t & 3) * 256 + col0 * 2;
        if (FULL) rq[t] = *(const LAS unsigned*)(rawb + RQ + o); rz[t] = *(const LAS unsigned*)(rawb + RZ + o); }
    float f[2][8], P[2][8], tot[2];
#pragma unroll
    for (int t = 0; t < 8; ++t) { f[0][t] = fast_exp2(h2f((unsigned short)(rz[t] & 0xffffu))); f[1][t] = fast_exp2(h2f((unsigned short)(rz[t] >> 16))); }
#pragma unroll
    for (int c = 0; c < 2; ++c) {
        if (DIR == 0) { P[c][7] = 1.0f;
#pragma unroll
            for (int t = 6; t >= 0; --t) P[c][t] = P[c][t + 1] * f[c][t + 1];
            tot[c] = P[c][0] * f[c][0];
        } else { P[c][0] = 1.0f;
#pragma unroll
            for (int t = 1; t < 8; ++t) P[c][t] = P[c][t - 1] * f[c][t - 1];
            tot[c] = P[c][7] * f[c][7];
        }
    }
    const int cpl = lane & 15;
    float Tq[2][4];
#pragma unroll
    for (int c = 0; c < 2; ++c)
#pragma unroll
        for (int j = 0; j < 4; ++j) Tq[c][j] = shfl_from(tot[c], cpl + 16 * j, lane);
    float post[2], dec[2];
#pragma unroll
    for (int c = 0; c < 2; ++c) {
        if (DIR == 0) post[c] = (tq < 3 ? Tq[c][3] : 1.0f) * (tq < 2 ? Tq[c][2] : 1.0f) * (tq < 1 ? Tq[c][1] : 1.0f);
        else post[c] = (tq > 0 ? Tq[c][0] : 1.0f) * (tq > 1 ? Tq[c][1] : 1.0f) * (tq > 2 ? Tq[c][2] : 1.0f);
        dec[c] = (Tq[c][0] * Tq[c][1]) * (Tq[c][2] * Tq[c][3]);
    }
    unsigned ksw[2][4]; float ksp[2] = {0.f, 0.f};
#pragma unroll
    for (int t = 0; t < 8; ++t) {
        const float P0 = P[0][t] * post[0], P1 = P[1][t] * post[1], ks0 = (1.0f - f[0][t]) * P0, ks1 = (1.0f - f[1][t]) * P1;
        if (FULL) { const float q0 = __uint_as_float(rq[t] << 16) * fast_rcp(P0), q1 = __uint_as_float(rq[t] & 0xffff0000u) * fast_rcp(P1);
            *(LAS unsigned*)(opb + OFF_QT + (8 * tq + t) * QT_P + col0 * 2) = cvtpk(q0, q1);
            *(LAS unsigned*)(opb + OFF_KT + (8 * tq + t) * QT_P + col0 * 2) = cvtpk(ks0, ks1); }
        if (t & 1) { ksw[0][t >> 1] = cvtpk(ksp[0], ks0); ksw[1][t >> 1] = cvtpk(ksp[1], ks1); } else { ksp[0] = ks0; ksp[1] = ks1; } }
    *(LAS u32x4*)(opb + OFF_KST + col0 * KS_P + tq * 16) = (u32x4){ksw[0][0], ksw[0][1], ksw[0][2], ksw[0][3]};
    *(LAS u32x4*)(opb + OFF_KST + (col0 + 1) * KS_P + tq * 16) = (u32x4){ksw[1][0], ksw[1][1], ksw[1][2], ksw[1][3]};
    if (tq == 0) *(LAS f32x2*)(opb + OFF_DEC + col0 * 4) = (f32x2){dec[0], dec[1]};
    if (!FULL) { gsum0 += __builtin_amdgcn_logf(dec[0]); gsum1 += __builtin_amdgcn_logf(dec[1]); }
}
__device__ __forceinline__ void vt_build(LAS unsigned char* opb, const LAS unsigned char* rawb, int col0, int tq) {
    unsigned rv[8];
#pragma unroll
    for (int t = 0; t < 8; ++t) rv[t] = *(const LAS unsigned*)(rawb + RV + (2 * tq + (t >> 2)) * RAW_GP + (t & 3) * 256 + col0 * 2);
    u32x4 v0, v1;
    v0.x = (rv[0] & 0xffffu) | (rv[1] << 16); v0.y = (rv[2] & 0xffffu) | (rv[3] << 16); v0.z = (rv[4] & 0xffffu) | (rv[5] << 16); v0.w = (rv[6] & 0xffffu) | (rv[7] << 16);
    v1.x = (rv[0] >> 16) | (rv[1] & 0xffff0000u); v1.y = (rv[2] >> 16) | (rv[3] & 0xffff0000u); v1.z = (rv[4] >> 16) | (rv[5] & 0xffff0000u); v1.w = (rv[6] >> 16) | (rv[7] & 0xffff0000u);
    *(LAS u32x4*)(opb + OFF_VT + col0 * KS_P + tq * 16) = v0;
    *(LAS u32x4*)(opb + OFF_VT + (col0 + 1) * KS_P + tq * 16) = v1;
}
__device__ __forceinline__ void state_decay(const LAS unsigned char* opb, f32x16 (&S)[4], int hh) {
    f32x4 d4[4][4];
#pragma unroll
    for (int m = 0; m < 4; ++m)
#pragma unroll
        for (int c = 0; c < 4; ++c) d4[m][c] = *(const LAS f32x4*)(opb + OFF_DEC + (32 * m + 8 * c + 4 * hh) * 4);
#pragma unroll
    for (int m = 0; m < 4; ++m)
#pragma unroll
        for (int c = 0; c < 4; ++c) { S[m][4 * c + 0] *= d4[m][c].x; S[m][4 * c + 1] *= d4[m][c].y; S[m][4 * c + 2] *= d4[m][c].z; S[m][4 * c + 3] *= d4[m][c].w; }
}
__device__ __forceinline__ void state_accum(const LAS unsigned char* opb, f32x16 (&S)[4], int n, int r32, int hh) {
    bf16x8 ka[4][2], vb[2];
#pragma unroll
    for (int s = 0; s < 2; ++s) vb[s] = *(const LAS bf16x8*)(opb + OFF_VT + (32 * n + r32) * KS_P + (16 * s + 8 * hh) * 2);
#pragma unroll
    for (int m = 0; m < 4; ++m)
#pragma unroll
        for (int s = 0; s < 2; ++s) ka[m][s] = *(const LAS bf16x8*)(opb + OFF_KST + (32 * m + r32) * KS_P + (16 * s + 8 * hh) * 2);
    __builtin_amdgcn_sched_barrier(0);
    __builtin_amdgcn_s_setprio(1);
#pragma unroll
    for (int m = 0; m < 4; ++m)
#pragma unroll
        for (int s = 0; s < 2; ++s) S[m] = MFMA32(ka[m][s], vb[s], S[m]);
    __builtin_amdgcn_s_setprio(0);
}
template <int DIR> __device__ __forceinline__ void at_build(const LAS unsigned char* opb, LAS unsigned char* pt, LAS unsigned* cnt, int w4, int lane) {
    const int qj = w4 >> 1, qi = w4 & 1, fr = lane & 15, fq = lane >> 4;
    f32x4 acc = {0.f, 0.f, 0.f, 0.f};
    bf16x8 ka[4], qb[4];
#pragma unroll
    for (int ks = 0; ks < 4; ++ks) { ka[ks] = *(const LAS bf16x8*)(opb + OFF_KT + (16 * qj + fr) * QT_P + (32 * ks + 8 * fq) * 2); qb[ks] = *(const LAS bf16x8*)(opb + OFF_QT + (16 * qi + fr) * QT_P + (32 * ks + 8 * fq) * 2); }
#pragma unroll
    for (int ks = 0; ks < 4; ++ks) acc = __builtin_amdgcn_mfma_f32_16x16x32_bf16(ka[ks], qb[ks], acc, 0, 0, 0);
    const int i = 16 * qi + fr, j0 = 16 * qj + 4 * fq;
#pragma unroll
    for (int e = 0; e < 4; ++e) { const bool keep = (DIR == 0) ? (j0 + e <= i) : (j0 + e >= i); acc[e] = keep ? acc[e] : 0.f; }
    u32x2 w; w.x = cvtpk(acc[0], acc[1]); w.y = cvtpk(acc[2], acc[3]);
    *(LAS u32x2*)(pt + i * PT_P + j0 * 2) = w;
    asm volatile("s_waitcnt lgkmcnt(0)" ::: "memory");
    if (lane == 0) __hip_atomic_fetch_add(cnt, 1u, __ATOMIC_RELAXED, __HIP_MEMORY_SCOPE_WORKGROUP);
}
template <int DIR> __device__ __forceinline__ f32x16 chunk_out(const LAS unsigned char* opb, const f32x16 (&S)[4], int n, int r32, int hh, const LAS unsigned char* pt, const LAS unsigned* cnt, unsigned target) {
    const LAS unsigned char* vrow = opb + OFF_VT + (32 * n + r32) * KS_P;
    const LAS unsigned char* qrow = opb + OFF_QT + r32 * QT_P;
    bf16x8 vf[2], qf[4][2];
#pragma unroll
    for (int s = 0; s < 2; ++s) vf[s] = ld8x2(vrow + (16 * s + 4 * hh) * 2, vrow + (16 * s + 8 + 4 * hh) * 2);
#pragma unroll
    for (int m = 0; m < 4; ++m)
#pragma unroll
        for (int s = 0; s < 2; ++s) qf[m][s] = ld8x2(qrow + (32 * m + 16 * s + 4 * hh) * 2, qrow + (32 * m + 16 * s + 8 + 4 * hh) * 2);
    f32x16 o;
#pragma unroll
    for (int i = 0; i < 16; ++i) o[i] = 0.f;
    __builtin_amdgcn_sched_barrier(0);
    __builtin_amdgcn_s_setprio(1);
#pragma unroll
    for (int m = 0; m < 4; ++m) {
        o = MFMA32(pack_step<0>(S[m]), qf[m][0], o);
        o = MFMA32(pack_step<1>(S[m]), qf[m][1], o);
    }
    __builtin_amdgcn_s_setprio(0);
    while ((unsigned)__builtin_amdgcn_readfirstlane((int)*(const volatile LAS unsigned*)cnt) < target) __builtin_amdgcn_s_sleep(1);
    asm volatile("" ::: "memory");
    const LAS unsigned char* prow = pt + r32 * PT_P;
    const bf16x8 p0 = ld8x2(prow + (4 * hh) * 2, prow + (8 + 4 * hh) * 2), p1 = ld8x2(prow + (16 + 4 * hh) * 2, prow + (24 + 4 * hh) * 2);
    __builtin_amdgcn_s_setprio(1);
    o = MFMA32(vf[0], p0, o);
    o = MFMA32(vf[1], p1, o);
    __builtin_amdgcn_s_setprio(0);
    return o;
}
constexpr int NSEG = 4, NCH = 32;
template <int DIR> __device__ __forceinline__ void combine(f32x16 (&S)[4], const float* st, const float* dl, int seg, int n, int lane, int hh) {
    const int cnt = DIR == 0 ? seg : NSEG - 1 - seg;
    for (int k = 0; k < cnt; ++k) { const int sp = DIR == 0 ? k : NSEG - 1 - k;
        const f32x4* stp = (const f32x4*)(st + (size_t)sp * 16384 + n * 4096) + lane; const float* dlp = dl + sp * 128 + 4 * hh;
#pragma unroll
        for (int m = 0; m < 4; ++m)
#pragma unroll
            for (int c = 0; c < 4; ++c) { const f32x4 d4 = *(const f32x4*)(dlp + 32 * m + 8 * c); const f32x4 sv = stp[(m * 4 + c) * 64];
#pragma unroll
                for (int e = 0; e < 4; ++e) S[m][4 * c + e] = S[m][4 * c + e] * fast_exp2(d4[e]) + sv[e]; }
    }
}
template <int MODE, int DIR> __device__ __forceinline__ void sweep(const Args& a, LAS unsigned char* lds, int task, int wid_s) {
    constexpr bool FULL = MODE != 0;
    constexpr int NS = FULL ? 2 : 4, D = NS - 1, NI = FULL ? 6 : 4, RAW_BYTES = (FULL ? 24 : 16) * RAW_GP;
    static_assert(OFF_RAW + NS * RAW_BYTES <= LDS_XB_OFF && OFF_STG + 4 * 32 * STG_P <= LDS_XB_OFF, "scan LDS map");
    const int b = task >> 5, h = (task >> 2) & 7, seg = task & 3;
    const int tidl = tid_local(wid_s), wave = __builtin_amdgcn_readfirstlane(tidl >> 6), w4 = wave & 3, lane = tidl & 63;
    const bool isM = wave >= 4;
    LAS unsigned* pcnt = (LAS unsigned*)(lds + OFF_PCNT);
    if (FULL && tidl == 0) *pcnt = 0u;
    const size_t tokseg = (size_t)b * 4096 + seg * (NCH * 32);
    const bf16_t* hgs = (const bf16_t*)(a.ws + WS_HG) + ((size_t)((b * 8 + h) * 128 + seg * NCH)) * 16384;
    float* stbase = (float*)a.out + ((size_t)((DIR * 64 + b * 8 + h) * NSEG)) * 16384;
    float* dlbase = (float*)(a.ws + WS_DL) + ((size_t)((DIR * 64 + b * 8 + h) * NSEG)) * 128;
#define SC_CH(i) (DIR == 0 ? (i) : NCH - 1 - (i))
    if (!isM) {
        const int tq = lane >> 4, col0 = 32 * w4 + 2 * (lane & 15);
        float gsum0 = 0.f, gsum1 = 0.f;
#pragma unroll
        for (int c = 0; c < D; ++c) issue_raw<FULL, DIR>(lds + OFF_RAW + c * RAW_BYTES, hgs + (size_t)SC_CH(c) * 16384, w4, lane);
        wait_younger<NI>(D - 1);
        SC_BAR();
        for (int i = -1; i < NCH; ++i) {
            if (FULL && i >= 0) at_build<DIR>(lds + OFF_OPB + (i & 1) * OPB_BYTES, lds + OFF_PT + (i & 1) * PT_BYTES, pcnt, w4, lane);
            if (i + 1 < NCH) {
                if (i + 1 + D < NCH) issue_raw<FULL, DIR>(lds + OFF_RAW + ((i + 1 + D) % NS) * RAW_BYTES, hgs + (size_t)SC_CH(i + 1 + D) * 16384, w4, lane);
                elem<FULL, DIR>(lds + OFF_OPB + ((i + 1) & 1) * OPB_BYTES, lds + OFF_RAW + ((i + 1) % NS) * RAW_BYTES, col0, tq, lane, gsum0, gsum1);
                if (SC_E2 && FULL) { float d0 = 0.f, d1 = 0.f; elem<FULL, DIR>(lds + OFF_OPB + ((i + 1) & 1) * OPB_BYTES, lds + OFF_RAW + ((i + 1) % NS) * RAW_BYTES, col0, tq, lane, d0, d1); }
                if (i + 2 < NCH) wait_younger<NI>((i + 1 + D < NCH - 1 ? i + 1 + D : NCH - 1) - (i + 2));
            }
            if (MODE == 2 && i >= 0) SC_BAR();
            SC_BAR();
        }
        if (MODE == 0 && tq == 0) *(f32x2*)(dlbase + seg * 128 + col0) = (f32x2){gsum0, gsum1};
    } else {
        const int r32 = lane & 31, hh = lane >> 5, n = w4;
        f32x16 S[4];
#pragma unroll
        for (int m = 0; m < 4; ++m)
#pragma unroll
            for (int i = 0; i < 16; ++i) S[m][i] = 0.f;
        if (MODE != 0) combine<DIR>(S, stbase, dlbase, seg, n, lane, hh);
        bf16_t* a2 = (bf16_t*)(a.ws + WS_A2);
        u32x2* obuf = (u32x2*)((unsigned char*)a.out + ST_BYTES) + ((size_t)(task * NCH) * 16 + n * 4) * 64 + lane;
        const u32x2* gbf = (const u32x2*)(a.ws + WS_GB) + ((size_t)(((b * 8 + h) * 128 + seg * NCH) * 16) + n * 4) * 64 + lane;
        u32x2 obn[4], gvn[4];
        if (MODE == 2) {
#pragma unroll
            for (int c4 = 0; c4 < 4; ++c4) { obn[c4] = obuf[(size_t)SC_CH(0) * 1024 + c4 * 64]; gvn[c4] = gbf[(size_t)SC_CH(0) * 1024 + c4 * 64]; } }
        const int vtq = lane >> 4, vcol0 = 32 * w4 + 2 * (lane & 15);
        SC_BAR();
        vt_build(lds + OFF_OPB, lds + OFF_RAW, vcol0, vtq);
        SC_BAR();
        for (int i = 0; i < NCH; ++i) {
            const LAS unsigned char* opb = lds + OFF_OPB + (i & 1) * OPB_BYTES;
            if (i + 1 < NCH) vt_build(lds + OFF_OPB + ((i + 1) & 1) * OPB_BYTES, lds + OFF_RAW + ((i + 1) % NS) * RAW_BYTES, vcol0, vtq);
            state_decay(opb, S, hh);
            if (MODE == 0) { state_accum(opb, S, n, r32, hh); }
            else {
                u32x2 ob[4], gv[4];
                if (MODE == 2) {
#pragma unroll
                    for (int c4 = 0; c4 < 4; ++c4) { ob[c4] = obn[c4]; gv[c4] = gvn[c4]; }
                    if (i + 1 < NCH) {
#pragma unroll
                        for (int c4 = 0; c4 < 4; ++c4) { obn[c4] = obuf[(size_t)SC_CH(i + 1) * 1024 + c4 * 64]; gvn[c4] = gbf[(size_t)SC_CH(i + 1) * 1024 + c4 * 64]; } } }
                f32x16 o = chunk_out<DIR>(opb, S, n, r32, hh, lds + OFF_PT + (i & 1) * PT_BYTES, pcnt, 4u * (unsigned)(i + 1));
                state_accum(opb, S, n, r32, hh);
                if (MODE == 1) {
#pragma unroll
                    for (int c4 = 0; c4 < 4; ++c4) { u32x2 w; w.x = cvtpk(o[4 * c4 + 0], o[4 * c4 + 1]); w.y = cvtpk(o[4 * c4 + 2], o[4 * c4 + 3]); obuf[(size_t)SC_CH(i) * 1024 + c4 * 64] = w; }
                } else {
                    float ss = 0.f;
#pragma unroll
                    for (int c4 = 0; c4 < 4; ++c4) { o[4 * c4 + 0] += bf2f(ob[c4].x & 0xffffu); o[4 * c4 + 1] += bf2f(ob[c4].x >> 16); o[4 * c4 + 2] += bf2f(ob[c4].y & 0xffffu); o[4 * c4 + 3] += bf2f(ob[c4].y >> 16);
                        ss += (o[4 * c4 + 0] * o[4 * c4 + 0] + o[4 * c4 + 1] * o[4 * c4 + 1]) + (o[4 * c4 + 2] * o[4 * c4 + 2] + o[4 * c4 + 3] * o[4 * c4 + 3]); }
                    ss += shflx(ss, 32, lane);
                    LAS float* red = (LAS float*)(lds + OFF_RED);
                    if (hh == 0) red[n * 32 + r32] = ss;
                    f32x4 wn[4];
#pragma unroll
                    for (int c4 = 0; c4 < 4; ++c4) wn[c4] = *(const f32x4*)(a.hg_norm_w + 32 * n + 8 * c4 + 4 * hh);
                    SC_BAR();
                    const float tot = (red[r32] + red[32 + r32]) + (red[64 + r32] + red[96 + r32]);
                    const float rstd = __builtin_amdgcn_rsqf(tot * (1.f / 128.f) + 1e-6f);
                    LAS unsigned char* stg = lds + OFF_STG + n * (32 * STG_P);
#pragma unroll
                    for (int c4 = 0; c4 < 4; ++c4) { u32x2 w;
                        w.x = cvtpk(o[4 * c4 + 0] * rstd * wn[c4].x * bf2f(gv[c4].x & 0xffffu), o[4 * c4 + 1] * rstd * wn[c4].y * bf2f(gv[c4].x >> 16));
                        w.y = cvtpk(o[4 * c4 + 2] * rstd * wn[c4].z * bf2f(gv[c4].y & 0xffffu), o[4 * c4 + 3] * rstd * wn[c4].w * bf2f(gv[c4].y >> 16));
                        *(LAS u32x2*)(stg + r32 * STG_P + (8 * c4 + 4 * hh) * 2) = w; }
                    bf16_t* arow = a2 + (tokseg + (size_t)SC_CH(i) * 32 + (lane >> 2)) * 1024 + h * 128 + 32 * n + (lane & 3) * 8;
#pragma unroll
                    for (int j = 0; j < 2; ++j) { const u32x4 w = *(const LAS u32x4*)(stg + ((lane >> 2) + 16 * j) * STG_P + (lane & 3) * 16); *(u32x4*)(arow + (size_t)j * 16 * 1024) = w; }
                }
            }
            SC_BAR();
        }
        if (MODE == 0) { f32x4* stp = (f32x4*)(stbase + (size_t)seg * 16384 + n * 4096) + lane;
#pragma unroll
            for (int m = 0; m < 4; ++m)
#pragma unroll
                for (int c = 0; c < 4; ++c) stp[(m * 4 + c) * 64] = (f32x4){S[m][4 * c + 0], S[m][4 * c + 1], S[m][4 * c + 2], S[m][4 * c + 3]}; }
    }
#undef SC_CH
}
constexpr int A2_OPB1 = OPB_BYTES - OFF_KST, A2_SLOT1 = OPB_BYTES + A2_OPB1, A2_DIR_BYTES = A2_SLOT1 + 16 * RAW_GP;
static_assert(16 * RAW_GP <= OFF_KST && 2 * A2_DIR_BYTES <= LDS_XB_OFF, "pass A LDS map");
__device__ __forceinline__ void sweep_a2(const Args& a, LAS unsigned char* lds, int task, int wid_s) {
    const int b = task >> 5, h = (task >> 2) & 7, seg = task & 3;
    const int tidl = tid_local(wid_s), wave = __builtin_amdgcn_readfirstlane(tidl >> 6), w4 = wave & 3, dir = wave >> 2, lane = tidl & 63;
    const bf16_t* hgs = (const bf16_t*)(a.ws + WS_HG) + ((size_t)((b * 8 + h) * 128 + seg * NCH)) * 16384;
    float* stbase = (float*)a.out + ((size_t)((dir * 64 + b * 8 + h) * NSEG)) * 16384;
    float* dlbase = (float*)(a.ws + WS_DL) + ((size_t)((dir * 64 + b * 8 + h) * NSEG)) * 128;
    LAS unsigned char* R = lds + dir * A2_DIR_BYTES;
    auto issue = [&](int i) __attribute__((always_inline)) {
        LAS unsigned char* rawb = R + (i & 1) * A2_SLOT1; const bf16_t* hgc = hgs + (size_t)(dir ? NCH - 1 - i : i) * 16384;
#pragma unroll
        for (int k = 0; k < 2; ++k) { const int grp = 2 * w4 + k; const bf16_t* src = hgc + grp * 512 + lane * 8;
            __builtin_amdgcn_global_load_lds((const unsigned*)(src + 4096 * (1 + dir)), (LAS unsigned*)(rawb + RZ + grp * RAW_GP), 16, 0, 0);
            __builtin_amdgcn_global_load_lds((const unsigned*)(src + 3 * 4096), (LAS unsigned*)(rawb + RV + grp * RAW_GP), 16, 0, 0); } };
    const int tq = lane >> 4, col0 = 32 * w4 + 2 * (lane & 15), r32 = lane & 31, hh = lane >> 5, n = w4;
    float gsum0 = 0.f, gsum1 = 0.f;
    f32x16 S[4];
#pragma unroll
    for (int m = 0; m < 4; ++m)
#pragma unroll
        for (int i = 0; i < 16; ++i) S[m][i] = 0.f;
    issue(0);
    SC_WAITV(0);
    SC_BAR();
    auto estage = [&](int i) __attribute__((always_inline)) { LAS unsigned char* opb = R + (i & 1) * A2_OPB1; const LAS unsigned char* rawb = R + (i & 1) * A2_SLOT1;
        if (dir == 0) elem<false, 0>(opb, rawb, col0, tq, lane, gsum0, gsum1); else elem<false, 1>(opb, rawb, col0, tq, lane, gsum0, gsum1);
        vt_build(opb, rawb, col0, tq); };
    auto mstage = [&](int i) __attribute__((always_inline)) { const LAS unsigned char* opp = R + (i & 1) * A2_OPB1; state_decay(opp, S, hh); state_accum(opp, S, n, r32, hh); };
    issue(1); estage(0); SC_WAITV(0); SC_BAR();
    for (int i = 1; i < NCH; ++i) {
        if (i + 1 < NCH) issue(i + 1);
        estage(i);
        mstage(i - 1);
        SC_WAITV(0);
        SC_BAR();
    }
    mstage(NCH - 1);
    if (tq == 0) *(f32x2*)(dlbase + seg * 128 + col0) = (f32x2){gsum0, gsum1};
    { f32x4* stp = (f32x4*)(stbase + (size_t)seg * 16384 + n * 4096) + lane;
#pragma unroll
      for (int m = 0; m < 4; ++m)
#pragma unroll
          for (int c = 0; c < 4; ++c) stp[(m * 4 + c) * 64] = (f32x4){S[m][4 * c + 0], S[m][4 * c + 1], S[m][4 * c + 2], S[m][4 * c + 3]}; }
}
}

#define XB_TMO      128
#define XB_XCNT(j)  (256  + 64 * (j))
#define XB_XSUB(j)  (1280 + 64 * (j))
#define XB_XGEN(j)  (2304 + 64 * (j))
#define XB_TOP      3328
#define XB_TOPGEN   3392
#define XCD_BAR_WORDS 3456
#define XB_SPIN_CAP (1u << 18)
constexpr int CTL_ZERO_BYTES = 16384;
__device__ __forceinline__ unsigned xb_ld(unsigned* p)              { return __hip_atomic_load(p, __ATOMIC_RELAXED, __HIP_MEMORY_SCOPE_AGENT); }
__device__ __forceinline__ unsigned xb_add(unsigned* p, unsigned v) { return __hip_atomic_fetch_add(p, v, __ATOMIC_RELAXED, __HIP_MEMORY_SCOPE_AGENT); }
__device__ __forceinline__ unsigned xb_xcc_id() { return (unsigned)__builtin_amdgcn_s_getreg((3 << 11) | 20) & 0xFu; }
#define XB_SPIN(cond, bar) do { unsigned _sp = 0; while (cond) { __builtin_amdgcn_s_sleep(1); \
    if ((++_sp & 255u) == 0u) { if (xb_ld(&(bar)[XB_TMO])) break; if (_sp > XB_SPIN_CAP) { atomicAdd(&(bar)[XB_TMO], 1u); break; } } } } while (0)
struct XcdBarrier { unsigned* bar; unsigned x; volatile LAS unsigned* st; };
__device__ __forceinline__ XcdBarrier xcd_barrier_post(unsigned* bar, volatile LAS unsigned* st) {
    XcdBarrier b; b.bar = bar; b.x = xb_xcc_id(); b.st = st;
    if (threadIdx.x == 0) (void)xb_add(&bar[XB_XCNT(b.x)], 1u);
    return b;
}
__device__ __forceinline__ void xcd_barrier_complete(unsigned* bar, unsigned x, unsigned& nloc, unsigned& nx) {
    const unsigned G = gridDim.x * gridDim.y * gridDim.z;
    unsigned sum, cnt, mine, sp = 0u;
    for (;;) {
        sum = 0u; cnt = 0u; mine = 0u;
#pragma unroll
        for (unsigned j = 0; j < 16; ++j) { const unsigned c = xb_ld(&bar[XB_XCNT(j)]); sum += c; cnt += (c > 0u) ? 1u : 0u; mine = (j == x) ? c : mine; }
        if (sum == G) break;
        __builtin_amdgcn_s_sleep(1);
        if ((++sp & 255u) == 0u) { if (xb_ld(&bar[XB_TMO])) break; if (sp > XB_SPIN_CAP) { atomicAdd(&bar[XB_TMO], 1u); break; } }
    }
    nloc = mine > 0u ? mine : 1u; nx = cnt > 0u ? cnt : 1u;
}
__device__ __forceinline__ void xcd_barrier(const XcdBarrier& b, int wid_s) {
    asm volatile("s_waitcnt vmcnt(0)" ::: "memory");
    __syncthreads();
    if (wid_s == 0 && lane_fresh() == 0) {
        unsigned* bar = b.bar;
        __builtin_amdgcn_s_waitcnt(0);
        unsigned nloc = b.st[0], nx = b.st[1];
        if (nloc == 0u) { xcd_barrier_complete(bar, b.x, nloc, nx); b.st[0] = nloc; b.st[1] = nx; }
        const unsigned old = xb_add(&bar[XB_XSUB(b.x)], 1u);
        const unsigned gen = old / nloc;
        if (old + 1u == (gen + 1u) * nloc) {
            __builtin_amdgcn_fence(__ATOMIC_RELEASE, "agent");
            asm volatile("s_waitcnt vmcnt(0)" ::: "memory");
            const unsigned og = xb_add(&bar[XB_TOP], 1u);
            const unsigned tg = og / nx;
            if (og + 1u == (tg + 1u) * nx) xb_add(&bar[XB_TOPGEN], 1u);
            else XB_SPIN(xb_ld(&bar[XB_TOPGEN]) == tg, bar);
            __builtin_amdgcn_fence(__ATOMIC_ACQUIRE, "agent");
            xb_add(&bar[XB_XGEN(b.x)], 1u);
            asm volatile("s_waitcnt vmcnt(0)" ::: "memory");
        } else {
            XB_SPIN(xb_ld(&bar[XB_XGEN(b.x)]) == gen, bar);
            __builtin_amdgcn_fence(__ATOMIC_ACQUIRE, "agent");
            asm volatile("s_waitcnt vmcnt(0)" ::: "memory");
        }
    }
    __syncthreads();
}

typedef const __attribute__((address_space(4))) Args* kargs_t;
__device__ __forceinline__ Args ldargs(kargs_t p) {
#if defined(__HIP_DEVICE_COMPILE__)
    asm volatile("" : "+s"(p)); return *p;
#else
    return Args{};
#endif
}
__global__ void __launch_bounds__(NTHREADS, 2) fwd_megakernel(Args a_unused) {
    extern __shared__ __attribute__((aligned(16))) unsigned char lds_raw[];
    LAS unsigned char* lds = (LAS unsigned char*)lds_raw;
    cg::grid_group grid = cg::this_grid();
    kargs_t kp = (kargs_t)__builtin_amdgcn_kernarg_segment_ptr();
    const int G = gridDim.x, bx = blockIdx.x;
    const int wid_s = __builtin_amdgcn_readfirstlane((int)threadIdx.x >> 6);
    const int vcu = (bx % 8) * (G / 8) + bx / 8;
    if (threadIdx.x < 16) ((LAS unsigned*)(lds + LDS_XB_OFF))[threadIdx.x] = 0u;
    __syncthreads();
    if (bx == 0) { const Args a = ldargs(kp); unsigned* ctl = (unsigned*)a.ws; for (int i = threadIdx.x; i < XCD_BAR_WORDS; i += NTHREADS) __hip_atomic_store(ctl + i, 0u, __ATOMIC_RELAXED, __HIP_MEMORY_SCOPE_AGENT); }
    grid.sync();
    XcdBarrier xbar; { const Args a = ldargs(kp); xbar = xcd_barrier_post((unsigned*)a.ws, (volatile LAS unsigned*)(lds + LDS_XB_OFF)); }

#define GSYNC() do { for (int _r = 0; _r < REP_SYNC; ++_r) xcd_barrier(xbar, wid_s); } while (0)
    for (int rep = 0; rep < REP_P0; ++rep) { const Args a = ldargs(kp); p0_prologue(a, lds, vcu, G, wid_s); }
    GSYNC();
    for (int rep = 0; rep < REP_P1; ++rep) { const Args a = ldargs(kp); unsigned char* ws = a.ws;
      EpiIn ein; ein.wsb = ws; ein.qkv = (bf16_t*)(ws + WS_QKV); ein.zg = (bf16_t*)a.out; ein.qnw = a.q_norm_w; ein.knw = a.k_norm_w; ein.lbf = a.lb_fwd; ein.lbb = a.lb_bwd; ein.pn0 = 0;
      pg8::Gemm g{(const bf16_t*)(ws + WS_H), (const bf16_t*)(ws + WS_WIN), MTOK, 20 * 256, 1024, STAGGER}; pg8::StaticOrder S; S.init(MTOK, 20 * 256, G, bx);
      pg8::gemm_phase<EpiIn, pg8::StaticOrder, P1_ALIGN, true, COVER_P1>(lds, g, S, ein, wid_s); }
    GSYNC();
    for (int rep = 0; rep < REP_ATT; ++rep) { const Args a = ldargs(kp); attn::phase(a, lds, vcu, wid_s); __syncthreads(); }
    GSYNC();
    for (int rep = 0; rep < REP_P1; ++rep) { const Args a = ldargs(kp); unsigned char* ws = a.ws;
      EpiIn ein; ein.wsb = ws; ein.qkv = (bf16_t*)(ws + WS_QKV); ein.zg = (bf16_t*)a.out; ein.qnw = a.q_norm_w; ein.knw = a.k_norm_w; ein.lbf = a.lb_fwd; ein.lbb = a.lb_bwd; ein.pn0 = 20;
      pg8::Gemm g{(const bf16_t*)(ws + WS_H), (const bf16_t*)(ws + WS_WIN) + (size_t)20 * 256 * 1024, MTOK, 20 * 256, 1024, STAGGER}; pg8::StaticOrder S; S.init(MTOK, 20 * 256, G, bx);
      pg8::gemm_phase<EpiIn, pg8::StaticOrder, P1_ALIGN, true, COVER_P1>(lds, g, S, ein, wid_s); }
    GSYNC();
    for (int rep = 0; rep < REP_SCA; ++rep) { const Args a = ldargs(kp); scan::sweep_a2(a, lds, vcu, wid_s); }
    GSYNC();
    for (int rep = 0; rep < REP_SCC; ++rep) { { const Args a = ldargs(kp); scan::sweep<1, 1>(a, lds, vcu, wid_s); } { const Args a = ldargs(kp); scan::sweep<2, 0>(a, lds, vcu, wid_s); } }
    GSYNC();
    for (int rep = 0; rep < REP_P3; ++rep) { const Args a = ldargs(kp); unsigned char* ws = a.ws; pg8::StaticOrder S; S.init(MTOK, 1024, G, bx);
      { const bf16_t* gw = (const bf16_t*)(ws + WS_WIN) + (size_t)40 * 256 * 1024; const bf16_t* Hh = (const bf16_t*)(ws + WS_H);
        pg8::Gemm4 g4{{Hh, Hh, (const bf16_t*)(ws + WS_A1), (const bf16_t*)(ws + WS_A2)}, {gw, gw, (const bf16_t*)(ws + WS_WA), (const bf16_t*)(ws + WS_WB)}, {1024, 1024, 512, 1024}, {4, 0, 0, 0}};
        EpiP3 E{EpiSig{(bf16_t*)(ws + WS_T1), (bf16_t*)(ws + WS_T2)}, EpiY2{(const bf16_t*)(ws + WS_T1), (const bf16_t*)(ws + WS_T2), (bf16_t*)(ws + WS_MG)}};
        pg8::gemm_phase4<EpiP3, pg8::StaticOrder>(lds, g4, S, E, wid_s); } }
    GSYNC();
    for (int rep = 0; rep < REP_P4; ++rep) { const Args a = ldargs(kp); unsigned char* ws = a.ws;
      pg8::Gemm g{(const bf16_t*)(ws + WS_MG), (const bf16_t*)(ws + WS_WO), MTOK, 1024, 1024}; pg8::StaticOrder S; S.init(MTOK, 1024, G, bx); EpiOut E{a.x, a.out};
      pg8::gemm_phase<EpiOut, pg8::StaticOrder, true, true>(lds, g, S, E, wid_s); }
}

extern "C" void kernel_launch(void* const* d_in, const int* in_sizes, int n_in, void* d_out, int out_size, void* d_ws, size_t ws_size, hipStream_t stream) {
    static int grid = 0;
    if (grid == 0) {
        if (n_in != 12 || in_sizes[0] != MTOK * DM || out_size != MTOK * DM || ws_size < WS_END) { fprintf(stderr, "kernel_launch: unexpected shapes (n_in %d, ws %zu)\n", n_in, ws_size); grid = -1; return; }
        int dev = 0, cus = 0, per_cu = 0;
        if (hipGetDevice(&dev) != hipSuccess || hipDeviceGetAttribute(&cus, hipDeviceAttributeMultiprocessorCount, dev) != hipSuccess) { grid = -1; return; }
        if (hipFuncSetAttribute((const void*)fwd_megakernel, hipFuncAttributeMaxDynamicSharedMemorySize, LDS_BYTES) != hipSuccess) { fprintf(stderr, "hipFuncSetAttribute failed\n"); grid = -1; return; }
        if (hipOccupancyMaxActiveBlocksPerMultiprocessor(&per_cu, (const void*)fwd_megakernel, NTHREADS, LDS_BYTES) != hipSuccess || per_cu < 1) { fprintf(stderr, "occupancy query: %d\n", per_cu); (void)hipGetLastError(); }
        grid = cus;
        if (grid != 256) { fprintf(stderr, "kernel_launch: built for a 256-CU device (got %d)\n", cus); grid = -1; return; }
    }
    if (grid < 0) return;
    Args a{};
    a.x = (const float*)d_in[0]; a.norm_w = (const float*)d_in[1]; a.w_in = (const float*)d_in[2]; a.q_norm_w = (const float*)d_in[3]; a.k_norm_w = (const float*)d_in[4]; a.rel_bias = (const float*)d_in[5];
    a.lb_fwd = (const float*)d_in[6]; a.lb_bwd = (const float*)d_in[7]; a.hg_norm_w = (const float*)d_in[8]; a.w_proj_a = (const float*)d_in[9]; a.w_proj_b = (const float*)d_in[10]; a.w_out = (const float*)d_in[11];
    a.out = (float*)d_out; a.ws = (unsigned char*)d_ws;
    void* args[] = {&a};
    hipError_t e = hipLaunchCooperativeKernel((void*)fwd_megakernel, dim3(grid), dim3(NTHREADS), args, LDS_BYTES, stream);
    if (e != hipSuccess) fprintf(stderr, "cooperative launch failed: %s (grid %d)\n", hipGetErrorString(e), grid);
}
```

```cpp
#include <hip/hip_runtime.h>
#include <hip/hip_cooperative_groups.h>
#include <cstdio>
#include <cstdint>
namespace cg = cooperative_groups;

#define LAS __attribute__((address_space(3)))
#define GAS __attribute__((address_space(1)))
typedef unsigned short bf16_t;
typedef short bf16x8 __attribute__((ext_vector_type(8)));
typedef float f32x4 __attribute__((ext_vector_type(4)));
typedef float f32x2 __attribute__((ext_vector_type(2)));
typedef unsigned u32x4 __attribute__((ext_vector_type(4)));
typedef unsigned u32x2 __attribute__((ext_vector_type(2)));

__device__ __forceinline__ int lane_fresh() { int z = 0; asm volatile("" : "+v"(z)); return (int)__builtin_amdgcn_mbcnt_hi(~0u, __builtin_amdgcn_mbcnt_lo(~0u, (unsigned)z)); }
__device__ __forceinline__ int tid_local(int wid_s) { return (wid_s << 6) | lane_fresh(); }

#define REP_P0 1
#define REP_P1 1
#define REP_ATT 1
#define REP_MRG 1
#define REP_SCA 1
#define REP_SCC 1
#define REP_P3 1
#define REP_P4 1
#define REP_SYNC 1
#define STAGGER 0
#define P1_ALIGN true
#define COVER_P1 false
#define REP_SCB 1
#define REP_SCF 1
#define SC_E2 0
#define SC_M2 0
#define SC_D2 0

constexpr int NBATCH = 8, SEQ = 4096, DM = 1024, MTOK = NBATCH * SEQ;
constexpr int INCOLS = 12288;
constexpr float LOG2E = 1.4426950408889634f;
constexpr int NTHREADS = 512, NWAVES = 8;
constexpr int LDS_BYTES = 163840;
constexpr int LDS_XB_OFF = 163776;

constexpr size_t MiB = 1u << 20;
constexpr size_t WS_WIN = 1 * MiB;
constexpr size_t WS_WA = 25 * MiB;
constexpr size_t WS_WB = 26 * MiB;
constexpr size_t WS_WO = 28 * MiB;
constexpr size_t WS_H = 32 * MiB;
constexpr size_t WS_X = 96 * MiB;
constexpr size_t WS_QKV = WS_X;
constexpr size_t WS_GA = 448 * MiB;
constexpr size_t WS_HG = WS_X;
constexpr size_t WS_GB = WS_X + 256 * MiB;
constexpr size_t WS_MG = WS_X;
constexpr size_t WS_T1 = WS_X + 64 * MiB, WS_T2 = WS_X + 128 * MiB;
constexpr size_t WS_A1 = 416 * MiB;
constexpr size_t WS_A2 = 448 * MiB;
constexpr size_t WS_END = 512 * MiB;

namespace pg8 {
constexpr int BM = 256, BK = 64, HALF = 128, HTB = HALF * BK * 2, STAGE_BYTES = 8 * HTB, NXCD = 8, WGM = 4;
__host__ __device__ __forceinline__ int lds_byte(int r, int c) { const int st = (r >> 4) * 2 + (c >> 5), rr = r & 15, cc = c & 31, ob = rr * 64 + cc * 2; return st * 1024 + (ob ^ (((ob >> 9) & 1) << 5)); }
__host__ __device__ __forceinline__ void stage_rc(int b, int& R, int& C) { const int st = b / 1024, sb = b % 1024, swz = sb ^ (((sb >> 9) & 1) << 5); R = (st >> 1) * 16 + swz / 64; C = (st & 1) * 32 + (swz % 64) / 2; }
struct Unit { int pm, pn; };
struct Gemm { const bf16_t* A; const bf16_t* Bt; int M, N, K; int stg = 0; };
struct StaticOrder {
    int nM, nN, nwg, G, c;
    __host__ __device__ void init(int M, int N, int G_, int c_) { nM = M / BM; nN = N / BM; nwg = nM * nN; G = G_; c = c_; }
    __host__ __device__ bool next(int i, Unit& u) const {
        const long L = (long)i * G + c; if (L >= nwg) return false;
        int wgid = (int)L; { const int q = nwg / NXCD, r = nwg % NXCD, xcd = wgid % NXCD, off = wgid / NXCD; wgid = (xcd < r ? xcd * (q + 1) : r * (q + 1) + (xcd - r) * q) + off; }
        const int nig = WGM * nN, gid = wgid / nig, fm = gid * WGM, gsz = (nM - fm) < WGM ? (nM - fm) : WGM;
        u.pm = fm + ((wgid % nig) % gsz); u.pn = (wgid % nig) / gsz; return true;
    }
    __device__ __forceinline__ void a_ready(const Unit&) const {}
    __device__ __forceinline__ void done(const Unit&) const {}
};
typedef __bf16 bf16x2v_t __attribute__((ext_vector_type(2)));
struct GateOrder : StaticOrder {
    __device__ bool next(int i, Unit& u) const { if (!StaticOrder::next(i >> 1, u)) return false; u.pn += 4 * ((i & 1) ^ 1); return true; }
};
__device__ __forceinline__ unsigned cvt_pk_bf16(float lo, float hi) { f32x2 v = {lo, hi}; bf16x2v_t b = __builtin_convertvector(v, bf16x2v_t); return __builtin_bit_cast(unsigned, b); }

template <class Epi, class Sched, bool ALIGN_EPI = false, bool SP2 = false, bool COVER = false>
__device__ __forceinline__ void gemm_phase(LAS unsigned char* lds, const Gemm g, const Sched& S, const Epi& E, int wid_s) {
    const int tid = tid_local(wid_s), wid = __builtin_amdgcn_readfirstlane(tid >> 6), lane = tid & 63, wr = wid >> 2, wc = wid & 3, fr = lane & 15, fq = lane >> 4;
    const int K = g.K, nt = K / BK;
    unsigned voffA, voffB;
    { int R, C; stage_rc(tid * 16, R, C); voffA = (unsigned)(R * K + C) * 2u; voffB = voffA; }
    const size_t rstep = (size_t)64 * K * 2;
    const size_t kstep = (size_t)(BK * 2);
    const size_t hstep = (size_t)HALF * K * 2;
    const size_t tstep = 2 * hstep;
    const unsigned ldsw = (unsigned)wid * 1024u;
    const int aoff = lds_byte(wr * 64 + fr, fq * 8), boff = lds_byte(wc * 32 + fr, fq * 8);
#define PG8_SA(b, h) (((b) * 2 + (h)) * HTB)
#define PG8_SB(b, h) ((4 + (b) * 2 + (h)) * HTB)
#define PG8_STAGE(bufoff, gbase, voff) do { _Pragma("unroll") for (int _i = 0; _i < 2; ++_i) \
        __builtin_amdgcn_global_load_lds((const unsigned*)((const char*)(gbase) + _i * rstep + (voff)), (LAS unsigned*)(lds + (bufoff) + ldsw + _i * 8192), 16, 0, 0); } while (0)
#define PG8_LDA(dst, b, h) do { _Pragma("unroll") for (int m = 0; m < 4; ++m) _Pragma("unroll") for (int k = 0; k < 2; ++k) dst[m][k] = *(const LAS bf16x8*)(lds + PG8_SA(b, h) + aoff + m * 2048 + k * 1024); } while (0)
#define PG8_LDB(dst, b, h) do { _Pragma("unroll") for (int n = 0; n < 2; ++n) _Pragma("unroll") for (int k = 0; k < 2; ++k) dst[n][k] = *(const LAS bf16x8*)(lds + PG8_SB(b, h) + boff + n * 2048 + k * 1024); } while (0)
#define PG8_MMA(ai, bj, At, Bt) do { __builtin_amdgcn_s_setprio(3); _Pragma("unroll") for (int m = 0; m < 4; ++m) _Pragma("unroll") for (int n = 0; n < 2; ++n) _Pragma("unroll") for (int k = 0; k < 2; ++k) \
        acc[ai][bj][m][n] = __builtin_amdgcn_mfma_f32_16x16x32_bf16(Bt[n][k], At[m][k], acc[ai][bj][m][n], 0, 0, 0); __builtin_amdgcn_s_setprio(0); } while (0)
#define PG8_MMAZ(ai, bj, At, Bt, FIRST) do { __builtin_amdgcn_s_setprio(3); \
        if (FIRST) { _Pragma("unroll") for (int m = 0; m < 4; ++m) _Pragma("unroll") for (int n = 0; n < 2; ++n) acc[ai][bj][m][n] = __builtin_amdgcn_mfma_f32_16x16x32_bf16(Bt[n][0], At[m][0], (f32x4){0.f, 0.f, 0.f, 0.f}, 0, 0, 0); } \
        else { _Pragma("unroll") for (int m = 0; m < 4; ++m) _Pragma("unroll") for (int n = 0; n < 2; ++n) acc[ai][bj][m][n] = __builtin_amdgcn_mfma_f32_16x16x32_bf16(Bt[n][0], At[m][0], acc[ai][bj][m][n], 0, 0, 0); } \
        _Pragma("unroll") for (int m = 0; m < 4; ++m) _Pragma("unroll") for (int n = 0; n < 2; ++n) acc[ai][bj][m][n] = __builtin_amdgcn_mfma_f32_16x16x32_bf16(Bt[n][1], At[m][1], acc[ai][bj][m][n], 0, 0, 0); \
        __builtin_amdgcn_s_setprio(0); } while (0)
#define PG8_WAIT_V(n) asm volatile("s_waitcnt vmcnt(" #n ")" ::: "memory")
#define PG8_WAIT_L(n) asm volatile("s_waitcnt lgkmcnt(" #n ")" ::: "memory")
#define PG8_BAR __builtin_amdgcn_s_barrier()
#define PG8_SCHED __builtin_amdgcn_sched_barrier(0)
    if (g.stg) { const int d = (S.c & 7) * g.stg; for (int q = 0; q < d; ++q) __builtin_amdgcn_s_sleep(127); }
    Unit cur, nxt; int ui = 0;
    if (!S.next(0, cur)) return;
    f32x4 acc[2][2][4][2];
#pragma unroll
    for (int a = 0; a < 2; ++a)
#pragma unroll
        for (int b = 0; b < 2; ++b)
#pragma unroll
            for (int m = 0; m < 4; ++m)
#pragma unroll
                for (int n = 0; n < 2; ++n) acc[a][b][m][n] = (f32x4){0.f, 0.f, 0.f, 0.f};
    bf16x8 At[4][2], B0[2][2], B1[2][2];
    const char* cA = (const char*)g.A + (size_t)cur.pm * tstep; const char* cB = (const char*)g.Bt + (size_t)cur.pn * tstep;
    S.a_ready(cur);
    if constexpr (SP2) {
        PG8_STAGE(PG8_SB(0, 0), cB, voffB); PG8_STAGE(PG8_SB(0, 1), cB + hstep, voffB); PG8_STAGE(PG8_SA(0, 0), cA, voffA); PG8_STAGE(PG8_SA(0, 1), cA + hstep, voffA);
        if (wr == 1) PG8_BAR;
        PG8_WAIT_V(2); PG8_BAR;
        PG8_STAGE(PG8_SB(1, 0), cB + kstep, voffB); PG8_STAGE(PG8_SA(1, 0), cA + kstep, voffA); PG8_STAGE(PG8_SB(1, 1), cB + hstep + kstep, voffB);
        if constexpr (COVER) { PG8_STAGE(PG8_SA(1, 1), cA + hstep + kstep, voffA); PG8_WAIT_V(0); } else PG8_WAIT_V(6);
        PG8_BAR;
    } else {
        PG8_STAGE(PG8_SB(0, 0), cB, voffB); PG8_STAGE(PG8_SA(0, 0), cA, voffA); PG8_STAGE(PG8_SB(0, 1), cB + hstep, voffB); PG8_STAGE(PG8_SA(0, 1), cA + hstep, voffA);
        if (wr == 1) PG8_BAR;
        PG8_WAIT_V(4); PG8_BAR;
        PG8_STAGE(PG8_SB(1, 0), cB + kstep, voffB); PG8_STAGE(PG8_SA(1, 0), cA + kstep, voffA); PG8_STAGE(PG8_SB(1, 1), cB + hstep + kstep, voffB);
        PG8_WAIT_V(6); PG8_BAR;
    }
    for (;;) {
        const bool has_next = S.next(ui + 1, nxt);
        const char* nA = has_next ? (const char*)g.A + (size_t)nxt.pm * tstep : cA; const char* nB = has_next ? (const char*)g.Bt + (size_t)nxt.pn * tstep : cB;
#define PG8_TRIP_SP2(T0) do { \
            PG8_LDB(B0, 0, 0); PG8_LDB(B1, 0, 1); PG8_SCHED; PG8_LDA(At, 0, 0); if (!(T0)) PG8_STAGE(PG8_SA(1, 1), a1 + hstep, voffA); \
            if (T0) PG8_WAIT_V(24); else PG8_WAIT_V(8); PG8_WAIT_L(0); PG8_BAR; PG8_MMAZ(0, 0, At, B0, t == 0); PG8_MMAZ(0, 1, At, B1, t == 0); PG8_BAR; PG8_SCHED; \
            PG8_LDA(At, 0, 1); PG8_STAGE(PG8_SB(0, 0), b2, voffB); PG8_STAGE(PG8_SB(0, 1), b2 + hstep, voffB); PG8_STAGE(PG8_SA(0, 0), a2, voffA); \
            if (T0) PG8_WAIT_V(24); else PG8_WAIT_V(8); PG8_WAIT_L(0); PG8_BAR; PG8_MMAZ(1, 0, At, B0, t == 0); PG8_MMAZ(1, 1, At, B1, t == 0); PG8_BAR; PG8_SCHED; \
            PG8_LDB(B0, 1, 0); PG8_LDB(B1, 1, 1); PG8_SCHED; PG8_LDA(At, 1, 0); PG8_STAGE(PG8_SA(0, 1), a2 + hstep, voffA); \
            if (T0) PG8_WAIT_V(24); else PG8_WAIT_V(8); PG8_WAIT_L(0); PG8_BAR; PG8_MMA(0, 0, At, B0); PG8_MMA(0, 1, At, B1); PG8_BAR; PG8_SCHED; \
            PG8_LDA(At, 1, 1); PG8_STAGE(PG8_SB(1, 0), b3, voffB); PG8_STAGE(PG8_SB(1, 1), b3 + hstep, voffB); PG8_STAGE(PG8_SA(1, 0), a3, voffA); \
            PG8_WAIT_V(8); PG8_WAIT_L(0); PG8_BAR; PG8_MMA(1, 0, At, B0); PG8_MMA(1, 1, At, B1); PG8_BAR; PG8_SCHED; } while (0)
        if constexpr (SP2 && COVER) {
            { const int t = 0; const char* a1 = cA + kstep; const char* a2 = cA + 2 * kstep; const char* b2 = cB + 2 * kstep; const char* a3 = a2 + kstep; const char* b3 = b2 + kstep; (void)a1;
              PG8_TRIP_SP2(true); }
        }
        for (int t = (SP2 && COVER) ? 2 : 0; t < nt; t += 2) {
            const bool last = (t == nt - 2);
            const char* a1 = cA + (size_t)(t + 1) * kstep;
            const char* a2 = last ? nA : cA + (size_t)(t + 2) * kstep; const char* b2 = last ? nB : cB + (size_t)(t + 2) * kstep;
            const char* a3 = a2 + kstep; const char* b3 = b2 + kstep;
            if (last && has_next) S.a_ready(nxt);
            if constexpr (SP2) {
            PG8_TRIP_SP2(false);
            } else {
            PG8_LDB(B0, 0, 0); PG8_SCHED; PG8_LDA(At, 0, 0); PG8_STAGE(PG8_SA(1, 1), a1 + hstep, voffA);
            PG8_WAIT_L(8); PG8_BAR; PG8_WAIT_L(0); PG8_MMA(0, 0, At, B0); PG8_BAR; PG8_SCHED;
            PG8_LDB(B1, 0, 1); PG8_STAGE(PG8_SB(0, 0), b2, voffB);
            PG8_BAR; PG8_WAIT_L(0); PG8_MMA(0, 1, At, B1); PG8_BAR;
            PG8_LDA(At, 0, 1); PG8_STAGE(PG8_SA(0, 0), a2, voffA);
            PG8_BAR; PG8_WAIT_L(0); PG8_MMA(1, 0, At, B0); PG8_BAR; PG8_SCHED;
            PG8_STAGE(PG8_SB(0, 1), b2 + hstep, voffB);
            PG8_WAIT_V(6); PG8_BAR; PG8_MMA(1, 1, At, B1); PG8_BAR;
            PG8_LDB(B0, 1, 0); PG8_SCHED; PG8_LDA(At, 1, 0); PG8_STAGE(PG8_SA(0, 1), a2 + hstep, voffA);
            PG8_WAIT_L(8); PG8_BAR; PG8_WAIT_L(0); PG8_MMA(0, 0, At, B0); PG8_BAR; PG8_SCHED;
            PG8_LDB(B1, 1, 1); PG8_STAGE(PG8_SB(1, 0), b3, voffB);
            PG8_BAR; PG8_WAIT_L(0); PG8_MMA(0, 1, At, B1); PG8_BAR;
            PG8_LDA(At, 1, 1); PG8_STAGE(PG8_SA(1, 0), a3, voffA);
            PG8_BAR; PG8_WAIT_L(0); PG8_MMA(1, 0, At, B0); PG8_BAR; PG8_SCHED;
            PG8_STAGE(PG8_SB(1, 1), b3 + hstep, voffB);
            PG8_WAIT_V(6); PG8_BAR; PG8_MMA(1, 1, At, B1); PG8_BAR;
            }
        }
        if constexpr (ALIGN_EPI) { if (wr == 0) PG8_BAR; }
        if constexpr (COVER) { PG8_STAGE(PG8_SA(1, 1), nA + hstep + kstep, voffA); asm volatile("" ::: "memory"); }
        { const int le = lane_fresh(); E(acc, cur, wr, wc, le & 15, le >> 4); } S.done(cur);
        if (!has_next) break;
        if constexpr (!SP2) {
#pragma unroll
        for (int a = 0; a < 2; ++a)
#pragma unroll
            for (int b = 0; b < 2; ++b)
#pragma unroll
                for (int m = 0; m < 4; ++m)
#pragma unroll
                    for (int n = 0; n < 2; ++n) acc[a][b][m][n] = (f32x4){0.f, 0.f, 0.f, 0.f};
        }
        cur = nxt; cA = nA; cB = nB; ++ui;
        if constexpr (ALIGN_EPI) { if (wr == 1) PG8_BAR; }
    }
    PG8_WAIT_V(0);
    if constexpr (!ALIGN_EPI) { if (wr == 0) PG8_BAR; }
    PG8_BAR;
#undef PG8_SA
#undef PG8_SB
#undef PG8_STAGE
#undef PG8_LDA
#undef PG8_LDB
#undef PG8_MMA
#undef PG8_WAIT_V
#undef PG8_WAIT_L
#undef PG8_BAR
#undef PG8_SCHED
#undef PG8_TRIP_SP2
#undef PG8_MMAZ
}
struct Gemm2 { const bf16_t* A[2]; const bf16_t* Bt[2]; int K[2]; };
__device__ __forceinline__ const char* uni64(const char* p) {
    const unsigned long long v = (unsigned long long)p;
    const unsigned lo = (unsigned)__builtin_amdgcn_readfirstlane((int)(unsigned)v), hi = (unsigned)__builtin_amdgcn_readfirstlane((int)(unsigned)(v >> 32));
    return (const char*)(((unsigned long long)hi << 32) | lo); }
template <class Epi, class Sched>
__device__ __forceinline__ void gemm_phase2(LAS unsigned char* lds, const Gemm2 g, const Sched& S, const Epi& E, int wid_s) {
    const int tid = tid_local(wid_s), wid = __builtin_amdgcn_readfirstlane(tid >> 6), lane = tid & 63, wr = wid >> 2, wc = wid & 3, fr = lane & 15, fq = lane >> 4;
    unsigned R2, C2;
    { int R, C; stage_rc(tid * 16, R, C); R2 = (unsigned)R * 2u; C2 = (unsigned)C * 2u; }
    const size_t kstep = (size_t)(BK * 2);
    const unsigned ldsw = (unsigned)wid * 1024u;
    const int aoff = lds_byte(wr * 64 + fr, fq * 8), boff = lds_byte(wc * 32 + fr, fq * 8);
#define PG8_SA(b, h) (((b) * 2 + (h)) * HTB)
#define PG8_SB(b, h) ((4 + (b) * 2 + (h)) * HTB)
#define PG8_STAGE2(bufoff, gbase, KK) do { const char* _gb = (const char*)(gbase); const unsigned _k = (unsigned)(KK); const unsigned _vo = R2 * _k + C2; \
        __builtin_amdgcn_global_load_lds((const unsigned*)(_gb + _vo), (LAS unsigned*)(lds + (bufoff) + ldsw), 16, 0, 0); \
        __builtin_amdgcn_global_load_lds((const unsigned*)(_gb + (size_t)128 * _k + _vo), (LAS unsigned*)(lds + (bufoff) + ldsw + 8192), 16, 0, 0); } while (0)
#define PG8_LDA(dst, b, h) do { _Pragma("unroll") for (int m = 0; m < 4; ++m) _Pragma("unroll") for (int k = 0; k < 2; ++k) dst[m][k] = *(const LAS bf16x8*)(lds + PG8_SA(b, h) + aoff + m * 2048 + k * 1024); } while (0)
#define PG8_LDB(dst, b, h) do { _Pragma("unroll") for (int n = 0; n < 2; ++n) _Pragma("unroll") for (int k = 0; k < 2; ++k) dst[n][k] = *(const LAS bf16x8*)(lds + PG8_SB(b, h) + boff + n * 2048 + k * 1024); } while (0)
#define PG8_MMA(ai, bj, At, Bt) do { __builtin_amdgcn_s_setprio(3); _Pragma("unroll") for (int m = 0; m < 4; ++m) _Pragma("unroll") for (int n = 0; n < 2; ++n) _Pragma("unroll") for (int k = 0; k < 2; ++k) \
        acc[ai][bj][m][n] = __builtin_amdgcn_mfma_f32_16x16x32_bf16(Bt[n][k], At[m][k], acc[ai][bj][m][n], 0, 0, 0); __builtin_amdgcn_s_setprio(0); } while (0)
#define PG8_MMAZ(ai, bj, At, Bt, FIRST) do { __builtin_amdgcn_s_setprio(3); \
        if (FIRST) { _Pragma("unroll") for (int m = 0; m < 4; ++m) _Pragma("unroll") for (int n = 0; n < 2; ++n) acc[ai][bj][m][n] = __builtin_amdgcn_mfma_f32_16x16x32_bf16(Bt[n][0], At[m][0], (f32x4){0.f, 0.f, 0.f, 0.f}, 0, 0, 0); } \
        else { _Pragma("unroll") for (int m = 0; m < 4; ++m) _Pragma("unroll") for (int n = 0; n < 2; ++n) acc[ai][bj][m][n] = __builtin_amdgcn_mfma_f32_16x16x32_bf16(Bt[n][0], At[m][0], acc[ai][bj][m][n], 0, 0, 0); } \
        _Pragma("unroll") for (int m = 0; m < 4; ++m) _Pragma("unroll") for (int n = 0; n < 2; ++n) acc[ai][bj][m][n] = __builtin_amdgcn_mfma_f32_16x16x32_bf16(Bt[n][1], At[m][1], acc[ai][bj][m][n], 0, 0, 0); \
        __builtin_amdgcn_s_setprio(0); } while (0)
#define PG8_WAIT_V(n) asm volatile("s_waitcnt vmcnt(" #n ")" ::: "memory")
#define PG8_WAIT_L(n) asm volatile("s_waitcnt lgkmcnt(" #n ")" ::: "memory")
#define PG8_BAR __builtin_amdgcn_s_barrier()
#define PG8_SCHED __builtin_amdgcn_sched_barrier(0)
    Unit cur, nxt; int ui = 0, seg = 0;
    if (!S.next(0, cur)) return;
    f32x4 acc[2][2][4][2];
#pragma unroll
    for (int a = 0; a < 2; ++a)
#pragma unroll
        for (int b = 0; b < 2; ++b)
#pragma unroll
            for (int m = 0; m < 4; ++m)
#pragma unroll
                for (int n = 0; n < 2; ++n) acc[a][b][m][n] = (f32x4){0.f, 0.f, 0.f, 0.f};
    bf16x8 At[4][2], B0[2][2], B1[2][2];
    size_t hs = (size_t)HALF * g.K[0] * 2;
    int ck = g.K[0];
    const char* cA = (const char*)g.A[0] + (size_t)cur.pm * 2 * hs; const char* cB = (const char*)g.Bt[0] + (size_t)cur.pn * 2 * hs;
    PG8_STAGE2(PG8_SB(0, 0), cB, ck); PG8_STAGE2(PG8_SB(0, 1), cB + hs, ck); PG8_STAGE2(PG8_SA(0, 0), cA, ck); PG8_STAGE2(PG8_SA(0, 1), cA + hs, ck);
    if (wr == 1) PG8_BAR;
    PG8_WAIT_V(2); PG8_BAR;
    PG8_STAGE2(PG8_SB(1, 0), cB + kstep, ck); PG8_STAGE2(PG8_SA(1, 0), cA + kstep, ck); PG8_STAGE2(PG8_SB(1, 1), cB + hs + kstep, ck);
    PG8_WAIT_V(6); PG8_BAR;
    for (;;) {
        bool has_next; const int nseg = seg ^ 1;
        if (seg == 0) { has_next = true; nxt = cur; } else has_next = S.next(ui + 1, nxt);
        const int fseg = has_next ? nseg : seg;
        const size_t nhs = (size_t)HALF * (fseg ? g.K[1] : g.K[0]) * 2;
        const int nk = fseg ? g.K[1] : g.K[0];
        const char* nA = has_next ? (const char*)(fseg ? g.A[1] : g.A[0]) + (size_t)nxt.pm * 2 * nhs : cA;
        const char* nB = has_next ? (const char*)(fseg ? g.Bt[1] : g.Bt[0]) + (size_t)nxt.pn * 2 * nhs : cB;
        const int nt = (seg ? g.K[1] : g.K[0]) / BK;
        for (int t = 0; t < nt; t += 2) {
            const bool last = (t == nt - 2);
            const char* a1 = cA + (size_t)(t + 1) * kstep;
            const char* a2 = last ? nA : cA + (size_t)(t + 2) * kstep; const char* b2 = last ? nB : cB + (size_t)(t + 2) * kstep;
            const char* a3 = a2 + kstep; const char* b3 = b2 + kstep;
            const size_t h2 = last ? nhs : hs; const int wk = last ? nk : ck;
            const bool fresh = (t == 0) && (seg == 0);
            PG8_LDB(B0, 0, 0); PG8_LDB(B1, 0, 1); PG8_SCHED; PG8_LDA(At, 0, 0); PG8_STAGE2(PG8_SA(1, 1), a1 + hs, ck);
            PG8_WAIT_V(8); PG8_WAIT_L(0); PG8_BAR; PG8_MMAZ(0, 0, At, B0, fresh); PG8_MMAZ(0, 1, At, B1, fresh); PG8_BAR; PG8_SCHED;
            PG8_LDA(At, 0, 1); PG8_STAGE2(PG8_SB(0, 0), b2, wk); PG8_STAGE2(PG8_SB(0, 1), b2 + h2, wk); PG8_STAGE2(PG8_SA(0, 0), a2, wk);
            PG8_WAIT_V(8); PG8_WAIT_L(0); PG8_BAR; PG8_MMAZ(1, 0, At, B0, fresh); PG8_MMAZ(1, 1, At, B1, fresh); PG8_BAR; PG8_SCHED;
            PG8_LDB(B0, 1, 0); PG8_LDB(B1, 1, 1); PG8_SCHED; PG8_LDA(At, 1, 0); PG8_STAGE2(PG8_SA(0, 1), a2 + h2, wk);
            PG8_WAIT_V(8); PG8_WAIT_L(0); PG8_BAR; PG8_MMA(0, 0, At, B0); PG8_MMA(0, 1, At, B1); PG8_BAR; PG8_SCHED;
            PG8_LDA(At, 1, 1); PG8_STAGE2(PG8_SB(1, 0), b3, wk); PG8_STAGE2(PG8_SB(1, 1), b3 + h2, wk); PG8_STAGE2(PG8_SA(1, 0), a3, wk);
            PG8_WAIT_V(8); PG8_WAIT_L(0); PG8_BAR; PG8_MMA(1, 0, At, B0); PG8_MMA(1, 1, At, B1); PG8_BAR; PG8_SCHED;
        }
        if (wr == 0) PG8_BAR;
        { const int le = lane_fresh();
          if (seg == 0) E.hook(acc, cur, wr, wc, le & 15, le >> 4);
          else E(acc, cur, wr, wc, le & 15, le >> 4); }
        if (!has_next) break;
        if (seg == 1) ++ui;
        cur = nxt; cA = nA; cB = nB; hs = nhs; ck = nk; seg = nseg;
        if (wr == 1) PG8_BAR;
    }
    PG8_WAIT_V(0);
    PG8_BAR;
#undef PG8_SA
#undef PG8_SB
#undef PG8_STAGE2
#undef PG8_MMAZ
#undef PG8_LDA
#undef PG8_LDB
#undef PG8_MMA
#undef PG8_WAIT_V
#undef PG8_WAIT_L
#undef PG8_BAR
#undef PG8_SCHED
}
struct Gemm4 { const bf16_t* A[4]; const bf16_t* Bt[4]; int K[4]; int bpn[4]; };
template <class Epi, class Sched>
__device__ __forceinline__ void gemm_phase4(LAS unsigned char* lds, const Gemm4 g, const Sched& S, const Epi& E, int wid_s) {
    const int tid = tid_local(wid_s), wid = __builtin_amdgcn_readfirstlane(tid >> 6), lane = tid & 63, wr = wid >> 2, wc = wid & 3, fr = lane & 15, fq = lane >> 4;
    unsigned R2_, C2;
    { int R, C; stage_rc(tid * 16, R, C); R2_ = (unsigned)R * 2u; C2 = (unsigned)C * 2u; }
    const size_t kstep = (size_t)(BK * 2);
    const unsigned ldsw = (unsigned)wid * 1024u;
    const int aoff = lds_byte(wr * 64 + fr, fq * 8), boff = lds_byte(wc * 32 + fr, fq * 8);
#define PG8_SA(b, h) (((b) * 2 + (h)) * HTB)
#define PG8_SB(b, h) ((4 + (b) * 2 + (h)) * HTB)
#define PG8_STAGE2(bufoff, gbase, KK) do { const char* _gb = (const char*)(gbase); const unsigned _k = (unsigned)(KK); const unsigned _vo = R2 * _k + C2; \
        __builtin_amdgcn_global_load_lds((const unsigned*)(_gb + _vo), (LAS unsigned*)(lds + (bufoff) + ldsw), 16, 0, 0); \
        __builtin_amdgcn_global_load_lds((const unsigned*)(_gb + (size_t)128 * _k + _vo), (LAS unsigned*)(lds + (bufoff) + ldsw + 8192), 16, 0, 0); } while (0)
#define PG8_LDA(dst, b, h) do { _Pragma("unroll") for (int m = 0; m < 4; ++m) _Pragma("unroll") for (int k = 0; k < 2; ++k) dst[m][k] = *(const LAS bf16x8*)(lds + PG8_SA(b, h) + aoff + m * 2048 + k * 1024); } while (0)
#define PG8_LDB(dst, b, h) do { _Pragma("unroll") for (int n = 0; n < 2; ++n) _Pragma("unroll") for (int k = 0; k < 2; ++k) dst[n][k] = *(const LAS bf16x8*)(lds + PG8_SB(b, h) + boff + n * 2048 + k * 1024); } while (0)
#define PG8_MMA(ai, bj, At, Bt) do { __builtin_amdgcn_s_setprio(3); _Pragma("unroll") for (int m = 0; m < 4; ++m) _Pragma("unroll") for (int n = 0; n < 2; ++n) _Pragma("unroll") for (int k = 0; k < 2; ++k) \
        ac[ai][bj][m][n] = __builtin_amdgcn_mfma_f32_16x16x32_bf16(Bt[n][k], At[m][k], ac[ai][bj][m][n], 0, 0, 0); __builtin_amdgcn_s_setprio(0); } while (0)
#define PG8_MMAZ(ai, bj, At, Bt, FIRST) do { __builtin_amdgcn_s_setprio(3); \
        if (FIRST) { _Pragma("unroll") for (int m = 0; m < 4; ++m) _Pragma("unroll") for (int n = 0; n < 2; ++n) ac[ai][bj][m][n] = __builtin_amdgcn_mfma_f32_16x16x32_bf16(Bt[n][0], At[m][0], (f32x4){0.f, 0.f, 0.f, 0.f}, 0, 0, 0); } \
        else { _Pragma("unroll") for (int m = 0; m < 4; ++m) _Pragma("unroll") for (int n = 0; n < 2; ++n) ac[ai][bj][m][n] = __builtin_amdgcn_mfma_f32_16x16x32_bf16(Bt[n][0], At[m][0], ac[ai][bj][m][n], 0, 0, 0); } \
        _Pragma("unroll") for (int m = 0; m < 4; ++m) _Pragma("unroll") for (int n = 0; n < 2; ++n) ac[ai][bj][m][n] = __builtin_amdgcn_mfma_f32_16x16x32_bf16(Bt[n][1], At[m][1], ac[ai][bj][m][n], 0, 0, 0); \
        __builtin_amdgcn_s_setprio(0); } while (0)
#define PG8_WAIT_V(n) asm volatile("s_waitcnt vmcnt(" #n ")" ::: "memory")
#define PG8_WAIT_L(n) asm volatile("s_waitcnt lgkmcnt(0)" ::: "memory")
#define PG8_BAR __builtin_amdgcn_s_barrier()
#define PG8_SCHED __builtin_amdgcn_sched_barrier(0)
    Unit cur, nxt;
    if (!S.next(0, cur)) return;
    bf16x8 At[4][2], B0[2][2], B1[2][2];
    auto kloop = [&](f32x4 (&ac)[2][2][4][2], const char* cA, const char* cB, int ck, const char* nA, const char* nB, int nk, const bool FRESH) __attribute__((always_inline)) {
        const size_t hs = (size_t)HALF * ck * 2, nhs = (size_t)HALF * nk * 2; const int nt = ck / BK;
        unsigned R2 = R2_; asm volatile("" : "+v"(R2));
        for (int t = 0; t < nt; t += 2) {
            const bool last = (t == nt - 2);
            const char* a1 = cA + (size_t)(t + 1) * kstep;
            const char* a2 = last ? nA : cA + (size_t)(t + 2) * kstep; const char* b2 = last ? nB : cB + (size_t)(t + 2) * kstep;
            const char* a3 = a2 + kstep; const char* b3 = b2 + kstep;
            const size_t h2 = last ? nhs : hs; const int wk = last ? nk : ck;
            const bool fresh = FRESH && (t == 0);
            PG8_LDB(B0, 0, 0); PG8_LDB(B1, 0, 1); PG8_SCHED; PG8_LDA(At, 0, 0); PG8_STAGE2(PG8_SA(1, 1), a1 + hs, ck);
            PG8_WAIT_V(8); PG8_WAIT_L(0); PG8_BAR; PG8_MMAZ(0, 0, At, B0, fresh); PG8_MMAZ(0, 1, At, B1, fresh); PG8_BAR; PG8_SCHED;
            PG8_LDA(At, 0, 1); PG8_STAGE2(PG8_SB(0, 0), b2, wk); PG8_STAGE2(PG8_SB(0, 1), b2 + h2, wk); PG8_STAGE2(PG8_SA(0, 0), a2, wk);
            PG8_WAIT_V(8); PG8_WAIT_L(0); PG8_BAR; PG8_MMAZ(1, 0, At, B0, fresh); PG8_MMAZ(1, 1, At, B1, fresh); PG8_BAR; PG8_SCHED;
            PG8_LDB(B0, 1, 0); PG8_LDB(B1, 1, 1); PG8_SCHED; PG8_LDA(At, 1, 0); PG8_STAGE2(PG8_SA(0, 1), a2 + h2, wk);
            PG8_WAIT_V(8); PG8_WAIT_L(0); PG8_BAR; PG8_MMA(0, 0, At, B0); PG8_MMA(0, 1, At, B1); PG8_BAR; PG8_SCHED;
            PG8_LDA(At, 1, 1); PG8_STAGE2(PG8_SB(1, 0), b3, wk); PG8_STAGE2(PG8_SB(1, 1), b3 + h2, wk); PG8_STAGE2(PG8_SA(1, 0), a3, wk);
            PG8_WAIT_V(8); PG8_WAIT_L(0); PG8_BAR; PG8_MMA(1, 0, At, B0); PG8_MMA(1, 1, At, B1); PG8_BAR; PG8_SCHED;
        } };
    auto segA = [&](int sg, const Unit& u) __attribute__((always_inline)) -> const char* { const char* q = (const char*)g.A[sg] + (size_t)u.pm * 2 * ((size_t)HALF * g.K[sg] * 2); asm volatile("" : "+s"(q)); return q; };
    auto segB = [&](int sg, const Unit& u) __attribute__((always_inline)) -> const char* { const char* q = (const char*)g.Bt[sg] + (size_t)(u.pn + g.bpn[sg]) * 2 * ((size_t)HALF * g.K[sg] * 2); asm volatile("" : "+s"(q)); return q; };
    { const char* cA = segA(0, cur); const char* cB = segB(0, cur); const int ck = g.K[0]; const size_t hs = (size_t)HALF * ck * 2; const unsigned R2 = R2_;
      PG8_STAGE2(PG8_SB(0, 0), cB, ck); PG8_STAGE2(PG8_SB(0, 1), cB + hs, ck); PG8_STAGE2(PG8_SA(0, 0), cA, ck); PG8_STAGE2(PG8_SA(0, 1), cA + hs, ck);
      if (wr == 1) PG8_BAR;
      PG8_WAIT_V(2); PG8_BAR;
      PG8_STAGE2(PG8_SB(1, 0), cB + kstep, ck); PG8_STAGE2(PG8_SA(1, 0), cA + kstep, ck); PG8_STAGE2(PG8_SB(1, 1), cB + hs + kstep, ck);
      PG8_WAIT_V(6); PG8_BAR; }
    for (int ui = 0;; ++ui) {
        const bool has_next = S.next(ui + 1, nxt);
        int upm = cur.pm, upn = cur.pn; asm volatile("" : "+s"(upm), "+s"(upn));
        const Unit cu{upm, upn};
        {   f32x4 accg[2][2][4][2];
            kloop(accg, segA(0, cur), segB(0, cur), g.K[0], segA(1, cur), segB(1, cur), g.K[1], true);
            if (wr == 0) PG8_BAR;
            { const int le = lane_fresh(); E.es.template run<true>(accg, cu.pm, cu.pn, wr, wc, le & 15, le >> 4); }
            if (wr == 1) PG8_BAR;
            kloop(accg, segA(1, cur), segB(1, cur), g.K[1], segA(2, cur), segB(2, cur), g.K[2], true);
            if (wr == 0) PG8_BAR;
            { const int le = lane_fresh(); E.es.template run<false>(accg, cu.pm, cu.pn, wr, wc, le & 15, le >> 4); }
            if (wr == 1) PG8_BAR; }
        {   f32x4 acc[2][2][4][2];
            kloop(acc, segA(2, cur), segB(2, cur), g.K[2], segA(3, cur), segB(3, cur), g.K[3], true);
            if (wr == 0) PG8_BAR;
            { const int le = lane_fresh(); E.ey.hook(acc, cu, wr, wc, le & 15, le >> 4); }
            if (wr == 1) PG8_BAR;
            kloop(acc, segA(3, cur), segB(3, cur), g.K[3], has_next ? segA(0, nxt) : segA(3, cur), has_next ? segB(0, nxt) : segB(3, cur), has_next ? g.K[0] : g.K[3], false);
            if (wr == 0) PG8_BAR;
            { const int le = lane_fresh(); E.ey(acc, cu, wr, wc, le & 15, le >> 4); } }
        if (!has_next) break;
        cur = nxt;
        if (wr == 1) PG8_BAR;
    }
    PG8_WAIT_V(0);
    PG8_BAR;
#undef PG8_SA
#undef PG8_SB
#undef PG8_STAGE2
#undef PG8_MMAZ
#undef PG8_LDA
#undef PG8_LDB
#undef PG8_MMA
#undef PG8_WAIT_V
#undef PG8_WAIT_L
#undef PG8_BAR
#undef PG8_SCHED
}
}

#define LDS_WAIT() asm volatile("s_waitcnt lgkmcnt(0)" ::: "memory")
__device__ __forceinline__ float bf2f(unsigned b) { return __uint_as_float(b << 16); }
__device__ __forceinline__ unsigned f2bf(float f) { unsigned u = __float_as_uint(f); return (u + 0x7fffu + ((u >> 16) & 1u)) >> 16; }
__device__ __forceinline__ unsigned pk2(float lo, float hi) { return f2bf(lo) | (f2bf(hi) << 16); }
__device__ __forceinline__ float fast_exp2(float x) { return __builtin_amdgcn_exp2f(x); }
__device__ __forceinline__ float fast_rcp(float x) { return __builtin_amdgcn_rcpf(x); }
__device__ __forceinline__ float sigmoidf_(float x) { return fast_rcp(1.0f + fast_exp2(-LOG2E * x)); }
__device__ __forceinline__ float siluf_(float x) { return x * sigmoidf_(x); }
__device__ __forceinline__ float h2f(unsigned short h) { return (float)__builtin_bit_cast(_Float16, h); }
__device__ __forceinline__ unsigned pkh2(float lo, float hi) { return (unsigned)__builtin_bit_cast(unsigned short, (_Float16)lo) | ((unsigned)__builtin_bit_cast(unsigned short, (_Float16)hi) << 16); }
__device__ __forceinline__ float shflx(float v, int mask, int lane) { return __builtin_bit_cast(float, __builtin_amdgcn_ds_bpermute((lane ^ mask) << 2, __builtin_bit_cast(int, v))); }
__device__ __forceinline__ float shfl_from(float v, int src, int) { return __builtin_bit_cast(float, __builtin_amdgcn_ds_bpermute(src << 2, __builtin_bit_cast(int, v))); }
__device__ __forceinline__ float wave_sum(float v, int lane) {
#pragma unroll
    for (int o = 1; o < 64; o <<= 1) v += shflx(v, o, lane);
    return v;
}
__host__ __device__ __forceinline__ int perm_pos_std(int o) { const int e = o & 3, n = (o >> 2) & 1, fq = (o >> 3) & 3, wc = (o >> 5) & 3, bj = (o >> 7) & 1; return (bj << 7) | (wc << 5) | (n << 4) | (fq << 2) | e; }
__host__ __device__ __forceinline__ int perm_pos_att(int o) { const int e = o & 3, n = (o >> 2) & 1, fq = (o >> 3) & 3, bj = (o >> 5) & 1, wc = (o >> 6) & 3; return (bj << 7) | (wc << 5) | (n << 4) | (fq << 2) | e; }
__device__ __forceinline__ int t5_bucket(int rel) {
    const int n = rel < 0 ? -rel : rel;
    int v = n < 8 ? n : (n <= 14 ? 8 : (n <= 26 ? 9 : (n <= 49 ? 10 : (n <= 90 ? 11 : (n <= 165 ? 12 : (n <= 304 ? 13 : (n <= 558 ? 14 : 15)))))));
    return (rel > 0 ? 16 : 0) + v;
}

struct Args {
    const float* x; const float* norm_w; const float* w_in; const float* q_norm_w; const float* k_norm_w; const float* rel_bias;
    const float* lb_fwd; const float* lb_bwd; const float* hg_norm_w; const float* w_proj_a; const float* w_proj_b; const float* w_out;
    float* out; unsigned char* ws;
};

template <int KIND>
__device__ __forceinline__ void p0_transpose_item(const float* W, int K, int N, bf16_t* WT, LAS float* scr, int item, int lane) {
    const int nblk = N / 32, kb = item / nblk, nb = item % nblk, k0 = 64 * kb, n0 = 32 * nb;
#pragma unroll 8
    for (int i = 0; i < 32; ++i) { const int kk = 2 * i + (lane >> 5); scr[kk * 33 + (lane & 31)] = W[(size_t)(k0 + kk) * N + n0 + (lane & 31)]; }
    LDS_WAIT(); asm volatile("" ::: "memory");
    const int c = lane & 7;
#pragma unroll
    for (int j = 0; j < 4; ++j) { const int n = (lane >> 3) + 8 * j; const LAS float* s = scr + (8 * c) * 33 + n;
        u32x4 o; o.x = pk2(s[0 * 33], s[1 * 33]); o.y = pk2(s[2 * 33], s[3 * 33]); o.z = pk2(s[4 * 33], s[5 * 33]); o.w = pk2(s[6 * 33], s[7 * 33]);
        const int col = n0 + n, tile = col >> 8, loc = col & 255;
        const int pos = (KIND == 1 && tile < 18) ? perm_pos_att(loc) : perm_pos_std(loc);
        *(u32x4*)(WT + (size_t)(tile * 256 + pos) * K + k0 + 8 * c) = o; }
    LDS_WAIT(); asm volatile("" ::: "memory");
}
__device__ __forceinline__ void p0_prologue(const Args& a, LAS unsigned char* lds, int vcu, int G, int wid_s) {
    const int tidl = tid_local(wid_s), lane = tidl & 63, wave = tidl >> 6;
    LAS float* scr = (LAS float*)(lds + wave * 16384);
    const int gw = vcu * NWAVES + wave, NGW = G * NWAVES;
    constexpr int I_IN = (1024 / 64) * (INCOLS / 32), I_A = (512 / 64) * (1024 / 32), I_B = (1024 / 64) * (1024 / 32), I_O = I_B;
    constexpr int NITEMS = I_IN + I_A + I_B + I_O;
    bf16_t* wtin = (bf16_t*)(a.ws + WS_WIN); bf16_t* wta = (bf16_t*)(a.ws + WS_WA); bf16_t* wtb = (bf16_t*)(a.ws + WS_WB); bf16_t* wto = (bf16_t*)(a.ws + WS_WO);
    for (int it = gw; it < NITEMS; it += NGW) {
        int r = it;
        if (r < I_IN) { p0_transpose_item<1>(a.w_in, 1024, INCOLS, wtin, scr, r, lane); continue; } r -= I_IN;
        if (r < I_A) { p0_transpose_item<0>(a.w_proj_a, 512, 1024, wta, scr, r, lane); continue; } r -= I_A;
        if (r < I_B) { p0_transpose_item<0>(a.w_proj_b, 1024, 1024, wtb, scr, r, lane); continue; } r -= I_B;
        p0_transpose_item<0>(a.w_out, 1024, 1024, wto, scr, r, lane);
    }
    bf16_t* H = (bf16_t*)(a.ws + WS_H);
    f32x4 w[4];
#pragma unroll
    for (int j = 0; j < 4; ++j) w[j] = ((const f32x4*)a.norm_w)[64 * j + lane];
    for (int m = gw; m < MTOK; m += NGW) {
        const f32x4* xr = (const f32x4*)(a.x + (size_t)m * DM) + lane;
        f32x4 v[4]; float s = 0.f;
#pragma unroll
        for (int j = 0; j < 4; ++j) { v[j] = xr[64 * j]; s += (v[j].x * v[j].x + v[j].y * v[j].y) + (v[j].z * v[j].z + v[j].w * v[j].w); }
        const float rstd = __builtin_amdgcn_rsqf(wave_sum(s, lane) * (1.f / DM) + 1e-6f);
        u32x2* o8 = (u32x2*)(H + (size_t)m * DM) + lane;
#pragma unroll
        for (int j = 0; j < 4; ++j) { u32x2 o; o.x = pk2(v[j].x * rstd * w[j].x, v[j].y * rstd * w[j].y); o.y = pk2(v[j].z * rstd * w[j].z, v[j].w * rstd * w[j].w); o8[64 * j] = o; }
    }
}

struct EpiIn {
    static constexpr bool PERM = false, AFTER_DRAIN = false;
    int pn0; unsigned char* wsb; bf16_t* qkv; bf16_t* zg; const float* qnw; const float* knw; const float* lbf; const float* lbb;
    template <bool NORM> __device__ __forceinline__ void att_tile(const f32x4 (&acc)[2][2][4][2], int row0, int g, int t, int h, int fr, int fq, const float* nw, float sc) const {
        const int sh = 2 * g;
        f32x4 wv[2][2];
        if (NORM) {
#pragma unroll
            for (int bj = 0; bj < 2; ++bj)
#pragma unroll
                for (int n = 0; n < 2; ++n) wv[bj][n] = *(const f32x4*)(nw + g * 64 + 8 * fq + 32 * bj + 4 * n) * sc; }
        bf16_t* tb = qkv + ((size_t)(((g * 3 + t) * 8) * 8 + h)) * 4096 * 64 + 8 * fq;
        float rs[2][4];
        if (NORM) {
#pragma unroll
            for (int ai = 0; ai < 2; ++ai)
#pragma unroll
                for (int m = 0; m < 4; ++m) { float ss = 0.f;
#pragma unroll
                    for (int bj = 0; bj < 2; ++bj)
#pragma unroll
                        for (int n = 0; n < 2; ++n) { const f32x4 v = acc[ai][bj][m][n]; ss += (v.x * v.x + v.y * v.y) + (v.z * v.z + v.w * v.w); }
                    rs[ai][m] = ss; }
            const int l16 = ((fq * 16 + fr) ^ 16) << 2, l32 = ((fq * 16 + fr) ^ 32) << 2;
#pragma unroll
            for (int ai = 0; ai < 2; ++ai)
#pragma unroll
                for (int m = 0; m < 4; ++m) rs[ai][m] += __builtin_bit_cast(float, __builtin_amdgcn_ds_bpermute(l16, __builtin_bit_cast(int, rs[ai][m])));
#pragma unroll
            for (int ai = 0; ai < 2; ++ai)
#pragma unroll
                for (int m = 0; m < 4; ++m) rs[ai][m] += __builtin_bit_cast(float, __builtin_amdgcn_ds_bpermute(l32, __builtin_bit_cast(int, rs[ai][m])));
#pragma unroll
            for (int ai = 0; ai < 2; ++ai)
#pragma unroll
                for (int m = 0; m < 4; ++m) rs[ai][m] = __builtin_amdgcn_rsqf(rs[ai][m] * (1.f / 64.f) + 1e-6f);
        }
#pragma unroll
        for (int ai = 0; ai < 2; ++ai)
#pragma unroll
            for (int m = 0; m < 4; ++m) {
                const int r = row0 + ai * 128 + m * 16, b = r >> 12, s = r & 4095;
                const int rowp = (s & ((1 << sh) - 1)) * (4096 >> sh) + (s >> sh);
                f32x4 v[2][2];
#pragma unroll
                for (int bj = 0; bj < 2; ++bj)
#pragma unroll
                    for (int n = 0; n < 2; ++n) { v[bj][n] = acc[ai][bj][m][n]; if (NORM) v[bj][n] = v[bj][n] * rs[ai][m] * wv[bj][n]; }
                bf16_t* dst = tb + ((size_t)(b * 8) * 4096 + rowp) * 64;
#pragma unroll
                for (int bj = 0; bj < 2; ++bj) { u32x4 w; w.x = pg8::cvt_pk_bf16(v[bj][0].x, v[bj][0].y); w.y = pg8::cvt_pk_bf16(v[bj][0].z, v[bj][0].w); w.z = pg8::cvt_pk_bf16(v[bj][1].x, v[bj][1].y); w.w = pg8::cvt_pk_bf16(v[bj][1].z, v[bj][1].w);
                    __builtin_nontemporal_store(w, (u32x4*)(dst + 32 * bj)); }
                __builtin_amdgcn_sched_barrier(0);
            }
    }
    template <int ACT, int LAY> __device__ __forceinline__ void ew_tile(const f32x4 (&acc)[2][2][4][2], int row0, int ct, int wc, int fq, bf16_t* base, int ldc, const float* lbp) const {
        f32x4 l0[2], l1[2];
        if (ACT == 3) {
#pragma unroll
            for (int bj = 0; bj < 2; ++bj) { const float* lp = lbp + (ct & 3) * 256 + bj * 128 + wc * 32 + 8 * fq;
                const f32x4 a00 = *(const f32x4*)lp, a01 = *(const f32x4*)(lp + 4), a10 = *(const f32x4*)(lp + 1024), a11 = *(const f32x4*)(lp + 1028);
#pragma unroll
                for (int j = 0; j < 4; ++j) { l0[bj][j] = fast_rcp(1.0f + fast_exp2(LOG2E * (a10[j] - a00[j]))); l1[bj][j] = fast_rcp(1.0f + fast_exp2(LOG2E * (a11[j] - a01[j]))); } } }
#pragma unroll
        for (int ai = 0; ai < 2; ++ai)
#pragma unroll
            for (int m = 0; m < 4; ++m) { const int rr = row0 + ai * 128 + m * 16;
                bf16_t* rowp;
                if (LAY == 0) rowp = base + (size_t)rr * ldc + ct * 256 + wc * 32 + 8 * fq;
                else if (LAY == 1) rowp = base + ((size_t)((((rr >> 12) * 8 + 2 * (ct & 3)) * 128 + ((rr & 4095) >> 5)) * 4 + (ct >> 2)) * 32 + (rr & 31)) * 128 + wc * 32 + 8 * fq;
                else rowp = base + ((size_t)(((((rr >> 12) * 8 + 2 * ct) * 128 + ((rr & 4095) >> 5)) * 4 + wc) * 4 + fq) * 64 + (rr & 31)) * 4;
#pragma unroll
                for (int bj = 0; bj < 2; ++bj) { f32x4 v0 = acc[ai][bj][m][0], v1 = acc[ai][bj][m][1];
                    u32x4 w;
                    if (ACT == 3) {
#pragma unroll
                        for (int j = 0; j < 4; ++j) { v0[j] = __builtin_amdgcn_logf(l0[bj][j] + (1.0f - l0[bj][j]) * sigmoidf_(v0[j])); v1[j] = __builtin_amdgcn_logf(l1[bj][j] + (1.0f - l1[bj][j]) * sigmoidf_(v1[j])); }
                        w.x = pkh2(v0.x, v0.y); w.y = pkh2(v0.z, v0.w); w.z = pkh2(v1.x, v1.y); w.w = pkh2(v1.z, v1.w);
                    } else {
                        if (ACT == 1) {
#pragma unroll
                            for (int j = 0; j < 4; ++j) { v0[j] = siluf_(v0[j]); v1[j] = siluf_(v1[j]); } }
                        w.x = pg8::cvt_pk_bf16(v0.x, v0.y); w.y = pg8::cvt_pk_bf16(v0.z, v0.w); w.z = pg8::cvt_pk_bf16(v1.x, v1.y); w.w = pg8::cvt_pk_bf16(v1.z, v1.w);
                    }
                    if (LAY == 2) { bf16_t* gp = rowp + (size_t)bj * (128 * 4 * 4 * 64 * 4);
                        __builtin_nontemporal_store((u32x2){w.x, w.y}, (u32x2*)gp); __builtin_nontemporal_store((u32x2){w.z, w.w}, (u32x2*)(gp + 32 * 4)); }
                    else __builtin_nontemporal_store(w, (u32x4*)(rowp + (LAY == 1 ? bj * (128 * 4 * 4096) : bj * 128))); }
                __builtin_amdgcn_sched_barrier(0); }
    }
    __device__ __forceinline__ void operator()(const f32x4 (&acc)[2][2][4][2], const pg8::Unit& u, int wr, int wc, int fr, int fq) const {
        const int T = __builtin_amdgcn_readfirstlane(pn0 + u.pn);
        const int row0 = __builtin_amdgcn_readfirstlane(u.pm) * 256 + wr * 64 + fr;
        if (T < 18) {
            const int g = T / 6, t = (T % 6) >> 1, h = ((T & 1) << 2) + wc;
            if (t == 0) att_tile<true>(acc, row0, g, 0, h, fr, fq, qnw, 0.125f * LOG2E);
            else if (t == 1) att_tile<true>(acc, row0, g, 1, h, fr, fq, knw, 1.0f);
            else att_tile<false>(acc, row0, g, 2, h, fr, fq, nullptr, 1.0f);
        }
        else if (T < 20) ew_tile<1, 0>(acc, row0, T - 18, wc, fq, (bf16_t*)(wsb + WS_GA), 512, nullptr);
        else if (T < 24) ew_tile<0, 1>(acc, row0, T - 20, wc, fq, (bf16_t*)(wsb + WS_HG), 0, nullptr);
        else if (T < 28) ew_tile<3, 1>(acc, row0, T - 20, wc, fq, (bf16_t*)(wsb + WS_HG), 0, lbf);
        else if (T < 32) ew_tile<3, 1>(acc, row0, T - 20, wc, fq, (bf16_t*)(wsb + WS_HG), 0, lbb);
        else if (T < 36) ew_tile<0, 1>(acc, row0, T - 20, wc, fq, (bf16_t*)(wsb + WS_HG), 0, nullptr);
        else ew_tile<1, 2>(acc, row0, T - 36, wc, fq, (bf16_t*)(wsb + WS_GB), 0, nullptr);
    }
};
struct EpiSig {
    static constexpr bool PERM = false, AFTER_DRAIN = false;
    bf16_t* t; bf16_t* t2;
    __device__ __forceinline__ void operator()(const f32x4 (&acc)[2][2][4][2], const pg8::Unit& u, int wr, int wc, int fr, int fq) const {
        const int pnu = __builtin_amdgcn_readfirstlane(u.pn);
        if (pnu >= 4) run<true>(acc, u.pm, pnu & 3, wr, wc, fr, fq); else run<false>(acc, u.pm, pnu, wr, wc, fr, fq); }
    template <bool isb> __device__ __forceinline__ void run(const f32x4 (&acc)[2][2][4][2], int upm, int pn4, int wr, int wc, int fr, int fq) const {
        const int row0 = upm * 256 + wr * 64 + fr, col0 = pn4 * 256 + wc * 32 + 8 * fq;
#pragma unroll
        for (int ai = 0; ai < 2; ++ai)
#pragma unroll
          for (int mp = 0; mp < 4; mp += 2) {
            u32x4 bz[2][2];
            if (!isb) {
#pragma unroll
                for (int mm = 0; mm < 2; ++mm)
#pragma unroll
                    for (int bj = 0; bj < 2; ++bj) bz[mm][bj] = *(const u32x4*)(t2 + (size_t)(row0 + ai * 128 + (mp + mm) * 16) * 1024 + col0 + bj * 128);
                asm volatile("" ::: "memory"); }
#pragma unroll
            for (int mm = 0; mm < 2; ++mm) { const int m = mp + mm; const size_t ro = (size_t)(row0 + ai * 128 + m * 16) * 1024 + col0;
#pragma unroll
                for (int bj = 0; bj < 2; ++bj) { const f32x4 v0 = acc[ai][bj][m][0], v1 = acc[ai][bj][m][1];
                    float o[8] = {sigmoidf_(v0.x), sigmoidf_(v0.y), sigmoidf_(v0.z), sigmoidf_(v0.w), sigmoidf_(v1.x), sigmoidf_(v1.y), sigmoidf_(v1.z), sigmoidf_(v1.w)};
                    if (!isb) { const u32x4 b4 = bz[mm][bj];
                        o[0] *= fast_rcp(bf2f(b4.x & 0xffffu)); o[1] *= fast_rcp(bf2f(b4.x >> 16)); o[2] *= fast_rcp(bf2f(b4.y & 0xffffu)); o[3] *= fast_rcp(bf2f(b4.y >> 16));
                        o[4] *= fast_rcp(bf2f(b4.z & 0xffffu)); o[5] *= fast_rcp(bf2f(b4.z >> 16)); o[6] *= fast_rcp(bf2f(b4.w & 0xffffu)); o[7] *= fast_rcp(bf2f(b4.w >> 16)); }
                    u32x4 w; w.x = pg8::cvt_pk_bf16(o[0], o[1]); w.y = pg8::cvt_pk_bf16(o[2], o[3]); w.z = pg8::cvt_pk_bf16(o[4], o[5]); w.w = pg8::cvt_pk_bf16(o[6], o[7]);
                    *(u32x4*)((isb ? t2 : t) + ro + bj * 128) = w; } }
            asm volatile("" ::: "memory");
          }
    }
};
struct EpiY2 {
    static constexpr bool PERM = false, AFTER_DRAIN = false;
    const bf16_t* t; const bf16_t* t2; bf16_t* mg;
    __device__ __forceinline__ void hook(f32x4 (&acc)[2][2][4][2], const pg8::Unit& u, int wr, int wc, int fr, int fq) const {
        int upm = u.pm, upn = u.pn; asm volatile("" : "+s"(upm), "+s"(upn));
        const int row0 = upm * 256 + wr * 64 + fr, col0 = upn * 256 + wc * 32 + 8 * fq;
        u32x4 gz[2][4][2];
#pragma unroll
        for (int ai = 0; ai < 2; ++ai)
#pragma unroll
            for (int m = 0; m < 4; ++m)
#pragma unroll
                for (int bj = 0; bj < 2; ++bj) gz[ai][m][bj] = *(const u32x4*)(t + (size_t)(row0 + ai * 128 + m * 16) * 1024 + col0 + bj * 128);
        asm volatile("" ::: "memory");
#pragma unroll
        for (int ai = 0; ai < 2; ++ai)
#pragma unroll
            for (int m = 0; m < 4; ++m)
#pragma unroll
                for (int bj = 0; bj < 2; ++bj) { const u32x4 g4 = gz[ai][m][bj];
                    acc[ai][bj][m][0].x *= bf2f(g4.x & 0xffffu); acc[ai][bj][m][0].y *= bf2f(g4.x >> 16); acc[ai][bj][m][0].z *= bf2f(g4.y & 0xffffu); acc[ai][bj][m][0].w *= bf2f(g4.y >> 16);
                    acc[ai][bj][m][1].x *= bf2f(g4.z & 0xffffu); acc[ai][bj][m][1].y *= bf2f(g4.z >> 16); acc[ai][bj][m][1].z *= bf2f(g4.w & 0xffffu); acc[ai][bj][m][1].w *= bf2f(g4.w >> 16); }
    }
    __device__ __forceinline__ void operator()(const f32x4 (&acc)[2][2][4][2], const pg8::Unit& u, int wr, int wc, int fr, int fq) const {
        int upm = u.pm, upn = u.pn; asm volatile("" : "+s"(upm), "+s"(upn));
        const int row0 = upm * 256 + wr * 64 + fr, col0 = upn * 256 + wc * 32 + 8 * fq;
        u32x4 gz[2][4][2];
#pragma unroll
        for (int ai = 0; ai < 2; ++ai)
#pragma unroll
            for (int m = 0; m < 4; ++m)
#pragma unroll
                for (int bj = 0; bj < 2; ++bj) gz[ai][m][bj] = *(const u32x4*)(t2 + (size_t)(row0 + ai * 128 + m * 16) * 1024 + col0 + bj * 128);
        asm volatile("" ::: "memory");
#pragma unroll
        for (int ai = 0; ai < 2; ++ai)
#pragma unroll
            for (int m = 0; m < 4; ++m) {
#pragma unroll
                for (int bj = 0; bj < 2; ++bj) { const u32x4 g4 = gz[ai][m][bj]; const f32x4 v0 = acc[ai][bj][m][0], v1 = acc[ai][bj][m][1];
                    u32x4 w;
                    w.x = pg8::cvt_pk_bf16(v0.x * bf2f(g4.x & 0xffffu), v0.y * bf2f(g4.x >> 16)); w.y = pg8::cvt_pk_bf16(v0.z * bf2f(g4.y & 0xffffu), v0.w * bf2f(g4.y >> 16));
                    w.z = pg8::cvt_pk_bf16(v1.x * bf2f(g4.z & 0xffffu), v1.y * bf2f(g4.z >> 16)); w.w = pg8::cvt_pk_bf16(v1.z * bf2f(g4.w & 0xffffu), v1.w * bf2f(g4.w >> 16));
                    *(u32x4*)(mg + (size_t)(row0 + ai * 128 + m * 16) * 1024 + col0 + bj * 128) = w; }
                __builtin_amdgcn_sched_barrier(0); }
    }
};
struct EpiP3 { EpiSig es; EpiY2 ey; };
struct EpiOut {
    static constexpr bool PERM = false, AFTER_DRAIN = false;
    const float* x; float* out;
    __device__ __forceinline__ void operator()(f32x4 (&acc)[2][2][4][2], const pg8::Unit& u, int wr, int wc, int fr, int fq) const {
        const int row0 = u.pm * 256 + wr * 64 + fr, col0 = u.pn * 256 + wc * 32 + 8 * fq;
#pragma unroll
        for (int ai = 0; ai < 2; ++ai) {
            f32x4 xv[4][2][2];
#pragma unroll
            for (int m = 0; m < 4; ++m) { const size_t off = (size_t)(row0 + ai * 128 + m * 16) * 1024 + col0;
#pragma unroll
                for (int bj = 0; bj < 2; ++bj)
#pragma unroll
                    for (int n = 0; n < 2; ++n) xv[m][bj][n] = __builtin_nontemporal_load((const f32x4*)(x + off + bj * 128 + 4 * n)); }
#pragma unroll
            for (int m = 0; m < 4; ++m)
#pragma unroll
                for (int bj = 0; bj < 2; ++bj)
#pragma unroll
                    for (int n = 0; n < 2; ++n) acc[ai][bj][m][n] += xv[m][bj][n];
            asm volatile("" ::: "memory");
        }
#pragma unroll
        for (int ai = 0; ai < 2; ++ai)
#pragma unroll
            for (int m = 0; m < 4; ++m) { const size_t off = (size_t)(row0 + ai * 128 + m * 16) * 1024 + col0;
#pragma unroll
                for (int bj = 0; bj < 2; ++bj)
#pragma unroll
                    for (int n = 0; n < 2; ++n) __builtin_nontemporal_store(acc[ai][bj][m][n], (f32x4*)(out + off + bj * 128 + 4 * n)); }
    }
};

typedef float f32x16 __attribute__((ext_vector_type(16)));
typedef short s16x4 __attribute__((ext_vector_type(4)));
typedef __bf16 bf16x2_t __attribute__((ext_vector_type(2)));
__device__ __forceinline__ unsigned cvtpk(float lo, float hi) { f32x2 v = {lo, hi}; bf16x2_t b = __builtin_convertvector(v, bf16x2_t); return __builtin_bit_cast(unsigned, b); }
template <int S_> __device__ __forceinline__ bf16x8 pack_step(const f32x16& x) {
    u32x4 p; p.x = cvtpk(x[8 * S_ + 0], x[8 * S_ + 1]); p.y = cvtpk(x[8 * S_ + 2], x[8 * S_ + 3]); p.z = cvtpk(x[8 * S_ + 4], x[8 * S_ + 5]); p.w = cvtpk(x[8 * S_ + 6], x[8 * S_ + 7]);
    return __builtin_bit_cast(bf16x8, p);
}
__device__ __forceinline__ bf16x8 ld8x2(const LAS unsigned char* p0, const LAS unsigned char* p1) { const s16x4 lo = *(const LAS s16x4*)p0, hi = *(const LAS s16x4*)p1; return __builtin_shufflevector(lo, hi, 0, 1, 2, 3, 4, 5, 6, 7); }
#define MFMA32(a, b, c) __builtin_amdgcn_mfma_f32_32x32x16_bf16((a), (b), (c), 0, 0, 0)
namespace attn {
typedef short v4i16_t __attribute__((ext_vector_type(4)));
__device__ __forceinline__ s16x4 vtr(const LAS unsigned char* p) { return __builtin_bit_cast(s16x4, __builtin_amdgcn_ds_read_tr16_b64_v4i16((LAS v4i16_t*)p)); }
constexpr int TAB_BYTES = 3 * 8 * 192 * 4;
constexpr int V_P = 192, VT_BYTES = 32 * V_P;
constexpr int OFF_VST = TAB_BYTES, OFF_OB = OFF_VST + 8 * VT_BYTES, OB_P = 32  ;
constexpr int OFF_ML = OFF_OB + 512 * OB_P * 4, LDS_NEED = OFF_ML + 512 * 8;
static_assert(LDS_NEED <= LDS_XB_OFF, "attention LDS map");
__device__ __forceinline__ int osw(int t) { return (t ^ (t >> 1) ^ (t >> 4)) & 31; }
__device__ __forceinline__ void phase(const Args& a, LAS unsigned char* lds, int vcu, int wid_s) {
    const int tidl = tid_local(wid_s), wave = __builtin_amdgcn_readfirstlane(tidl >> 6), lane = tidl & 63, r32 = lane & 31, hh = lane >> 5;
    LAS float* tab = (LAS float*)lds;
    for (int e = tidl; e < 3 * 8 * 192; e += NTHREADS) { const int idx = e % 192, gh = e / 192, g = gh >> 3, rel = idx - 95;
        float v = 0.f; if (rel >= -64 && rel <= 64) v = a.rel_bias[t5_bucket(rel * (1 << (2 * g))) * 24 + gh] * LOG2E;
        tab[e] = v; }
    __syncthreads();
    LAS unsigned char* vl = lds + OFF_VST + wave * VT_BYTES;
    LAS unsigned* ob = (LAS unsigned*)(lds + OFF_OB); LAS f32x2* mlb = (LAS f32x2*)(lds + OFF_ML);
    const bf16_t* qkv = (const bf16_t*)(a.ws + WS_QKV);
    const int trq = (lane & 15) >> 2, trp = lane & 3, trblk = (lane >> 4) & 1;
    const LAS unsigned char* vtr0 = vl + (4 * hh + trq) * V_P + (16 * trblk + 4 * trp) * 2;
    struct Item { const bf16_t* Q; const bf16_t* K; const bf16_t* V; const LAS float* tgh; int ft, aidx, ntl, tstr, tofs, d0, d1, g, b, h, w; };
    auto item_info = [&](int n) -> Item {
        Item it; const int tk = n / 6, g = (n % 6) >> 1, qq = n & 1, task = vcu * 2 + tk, b = task >> 6, h = (task >> 3) & 7, w = task & 7, q = wave * 2 + qq, sh = 2 * g;
        it.g = g; it.b = b; it.h = h; it.w = w; it.ntl = 128 >> sh;
        int r;
        if (g == 0) { r = 0; it.aidx = 16 * w + q; it.tstr = 1; it.tofs = 32 * q; }
        else if (g == 1) { r = q >> 2; it.aidx = 4 * w + (q & 3); it.tstr = 4; it.tofs = 128 * (q & 3) + r; }
        else { r = q; it.aidx = w; it.tstr = 16; it.tofs = r; }
        it.ft = r * it.ntl + it.aidx;
        it.Q = qkv + ((size_t)((((g * 3 + 0) * 8 + b) * 8 + h)) * 4096) * 64;
        it.K = qkv + ((size_t)((((g * 3 + 1) * 8 + b) * 8 + h)) * 4096) * 64;
        it.V = qkv + ((size_t)((((g * 3 + 2) * 8 + b) * 8 + h)) * 4096) * 64;
        it.tgh = tab + (g * 8 + h) * 192;
        it.d0 = it.aidx >= 2 ? -2 : -it.aidx; it.d1 = (it.ntl - 1 - it.aidx) >= 2 ? 2 : (it.ntl - 1 - it.aidx);
        return it; };
    struct Unit2 { Item A, B; bool hasb; int X0, X1, A0, A1, B0, B1; };
    auto unit_info = [&](int u) -> Unit2 {
        Unit2 U; const int tk = u >> 2, j = u & 3;
        if (j < 2) { U.A = item_info((tk * 3 + j) * 2); U.B = item_info((tk * 3 + j) * 2 + 1); U.hasb = true; }
        else { U.A = item_info((tk * 3 + 2) * 2 + (j - 2)); U.B = U.A; U.hasb = false; }
        U.A0 = U.A.ft + U.A.d0; U.A1 = U.A.ft + U.A.d1; U.B0 = U.B.ft + U.B.d0; U.B1 = U.B.ft + U.B.d1;
        U.X0 = U.A0; U.X1 = U.hasb ? U.B1 : U.A1;
        return U; };
    bf16x8 qa[4], qb[4], kf[4]; u32x4 vr[4];
    auto loadk = [&](const bf16_t* Kp, int kt) __attribute__((always_inline)) {
        int ln = lane; asm volatile("" : "+v"(ln));
        const bf16_t* kp = Kp + ((size_t)(32 * kt) + (ln & 31)) * 64 + 8 * (ln >> 5);
#pragma unroll
        for (int s = 0; s < 4; ++s) kf[s] = *(const bf16x8*)(kp + 16 * s); };
    auto loadv = [&](const bf16_t* Vp, int kt) __attribute__((always_inline)) {
        int ln = lane; asm volatile("" : "+v"(ln));
        const bf16_t* vp = Vp + ((size_t)(32 * kt) + (ln >> 3)) * 64 + (ln & 7) * 8;
#pragma unroll
        for (int j = 0; j < 4; ++j) vr[j] = *(const u32x4*)(vp + (size_t)j * 8 * 64); };
    auto loadq = [&](bf16x8 (&q)[4], const Item& it) __attribute__((always_inline)) {
        int ln = lane; asm volatile("" : "+v"(ln));
        const bf16_t* qp = it.Q + ((size_t)(32 * it.ft) + (ln & 31)) * 64 + 8 * (ln >> 5);
#pragma unroll
        for (int s = 0; s < 4; ++s) q[s] = *(const bf16x8*)(qp + 16 * s); };
    Unit2 cur = unit_info(0);
    const bool down = (wave & 1) != 0;
    loadq(qa, cur.A); loadq(qb, cur.B); loadk(cur.A.K, down ? cur.X1 : cur.X0); loadv(cur.A.V, down ? cur.X1 : cur.X0);
    for (int u = 0; u < 8; ++u) {
        const Unit2 nxt = unit_info(u + 1 < 8 ? u + 1 : u);
        const int g = cur.A.g;
        f32x16 OA0, OA1, OB0, OB1;
#pragma unroll
        for (int i = 0; i < 16; ++i) { OA0[i] = 0.f; OA1[i] = 0.f; OB0[i] = 0.f; OB1[i] = 0.f; }
        float mA = 0.f, lA = 0.f, mB = 0.f, lB = 0.f;
        const int rr = r32 - 4 * hh;
        auto scores = [&](f32x16& st, const Item& it, const bf16x8 (&q)[4], int dl, float mref) __attribute__((always_inline)) {
            const LAS float* tl = it.tgh + (32 * dl + 95 - r32 + 4 * hh);
#pragma unroll
            for (int reg = 0; reg < 16; ++reg) st[reg] = tl[(reg & 3) + 8 * (reg >> 2)] - mref;
#pragma unroll
            for (int s = 0; s < 4; ++s) st = MFMA32(kf[s], q[s], st); };
        auto softmax = [&](f32x16& st, int dl, float& mrun, float& lrun, f32x16& O0, f32x16& O1) __attribute__((always_inline)) {
            float mx = -1e30f;
            if (dl == -2) {
#pragma unroll
                for (int reg = 0; reg < 16; ++reg) { const int jo = (reg & 3) + 8 * (reg >> 2); const float v = (jo >= rr) ? st[reg] : -1e30f; st[reg] = v; mx = fmaxf(mx, v); }
            } else if (dl == 2) {
#pragma unroll
                for (int reg = 0; reg < 16; ++reg) { const int jo = (reg & 3) + 8 * (reg >> 2); const float v = (jo <= rr) ? st[reg] : -1e30f; st[reg] = v; mx = fmaxf(mx, v); }
            } else {
#pragma unroll
                for (int reg = 0; reg < 16; ++reg) mx = fmaxf(mx, st[reg]);
            }
            mx = fmaxf(mx, shflx(mx, 32, lane));
            float ps = 0.f;
            if (__all(mx <= 6.0f)) {
#pragma unroll
                for (int reg = 0; reg < 16; ++reg) { const float pv = fast_exp2(st[reg]); st[reg] = pv; ps += pv; }
                lrun += ps;
            } else {
                const float mn = fmaxf(mx, 0.f), al = fast_exp2(-mn);
#pragma unroll
                for (int reg = 0; reg < 16; ++reg) { const float pv = fast_exp2(st[reg] - mn); st[reg] = pv; ps += pv; }
                lrun = lrun * al + ps; mrun += mn;
#pragma unroll
                for (int i = 0; i < 16; ++i) { O0[i] *= al; O1[i] *= al; }
            } };
        const int nk = cur.X1 - cur.X0;
        for (int i = 0; i <= nk; ++i) {
            const int kt = down ? cur.X1 - i : cur.X0 + i, ktn = down ? kt - 1 : kt + 1;
            const bool actA = kt <= cur.A1, actB = cur.hasb && kt >= cur.B0;
            const bool lastt = i == nk;
            const int dlA = kt - cur.A.ft, dlB = kt - cur.B.ft;
            f32x16 sA, sB;
            if (actA) scores(sA, cur.A, qa, dlA, mA);
            if (actB) scores(sB, cur.B, qb, dlB, mB);
            loadk(lastt ? nxt.A.K : cur.A.K, lastt ? (down ? nxt.X1 : nxt.X0) : ktn);
            if (lastt) { loadq(qa, nxt.A); if (nxt.hasb) loadq(qb, nxt.B); }
            if (actA) softmax(sA, dlA, mA, lA, OA0, OA1);
            if (actB) softmax(sB, dlB, mB, lB, OB0, OB1);
            { int ln = lane; asm volatile("" : "+v"(ln));
              LAS unsigned char* vw = vl + (ln >> 3) * V_P + (ln & 7) * 16;
#pragma unroll
              for (int j = 0; j < 4; ++j) *(LAS u32x4*)(vw + j * 8 * V_P) = vr[j]; }
            loadv(lastt ? nxt.A.V : cur.A.V, lastt ? (down ? nxt.X1 : nxt.X0) : ktn);
            const s16x4 a00 = vtr(vtr0), a01 = vtr(vtr0 + 8 * V_P), a10 = vtr(vtr0 + 16 * V_P), a11 = vtr(vtr0 + 24 * V_P);
            const s16x4 b00 = vtr(vtr0 + 64), b01 = vtr(vtr0 + 8 * V_P + 64), b10 = vtr(vtr0 + 16 * V_P + 64), b11 = vtr(vtr0 + 24 * V_P + 64);
            const bf16x8 va0 = __builtin_shufflevector(a00, a01, 0, 1, 2, 3, 4, 5, 6, 7), va1 = __builtin_shufflevector(a10, a11, 0, 1, 2, 3, 4, 5, 6, 7);
            const bf16x8 vb0 = __builtin_shufflevector(b00, b01, 0, 1, 2, 3, 4, 5, 6, 7), vb1 = __builtin_shufflevector(b10, b11, 0, 1, 2, 3, 4, 5, 6, 7);
            if (actA) { const bf16x8 p0 = pack_step<0>(sA), p1 = pack_step<1>(sA);
                OA0 = MFMA32(va0, p0, OA0); OA0 = MFMA32(va1, p1, OA0); OA1 = MFMA32(vb0, p0, OA1); OA1 = MFMA32(vb1, p1, OA1); }
            if (actB) { const bf16x8 p0 = pack_step<0>(sB), p1 = pack_step<1>(sB);
                OB0 = MFMA32(va0, p0, OB0); OB0 = MFMA32(va1, p1, OB0); OB1 = MFMA32(vb0, p0, OB1); OB1 = MFMA32(vb1, p1, OB1); }
        }
        auto merge = [&](const Item& it, const f32x16& O0, const f32x16& O1, float mrun, float lrun) __attribute__((always_inline)) {
            const float ltot = lrun + shflx(lrun, 32, lane);
            const int tloc = r32 * it.tstr + it.tofs;
            float sc0, sc1;
            if (g == 0) { sc0 = 0.f; sc1 = fast_rcp(ltot); if (hh == 0) mlb[tloc] = (f32x2){mrun, ltot}; }
            else { const f32x2 mlo = mlb[tloc]; const float Mn = fmaxf(mlo.x, mrun), wa = mlo.y * fast_exp2(mlo.x - Mn), wb = fast_exp2(mrun - Mn), Ln = wa + ltot * wb, inv = fast_rcp(Ln);
                sc0 = wa * inv; sc1 = wb * inv; if (hh == 0) mlb[tloc] = (f32x2){Mn, Ln}; }
            LAS unsigned* orow = ob + tloc * OB_P; const int fs = osw(tloc), hx = 2 * hh;
#define OBW(k) orow[((k) + hx) ^ fs]
#pragma unroll
            for (int c = 0; c < 4; ++c) {
                float v0[4], v1[4];
#pragma unroll
                for (int e = 0; e < 4; ++e) { v0[e] = O0[4 * c + e] * sc1; v1[e] = O1[4 * c + e] * sc1; }
                if (g != 0) { const unsigned a0 = OBW(4 * c), a1 = OBW(4 * c + 1), b0 = OBW(16 + 4 * c), b1 = OBW(16 + 4 * c + 1);
                    v0[0] += sc0 * bf2f(a0 & 0xffffu); v0[1] += sc0 * bf2f(a0 >> 16); v0[2] += sc0 * bf2f(a1 & 0xffffu); v0[3] += sc0 * bf2f(a1 >> 16);
                    v1[0] += sc0 * bf2f(b0 & 0xffffu); v1[1] += sc0 * bf2f(b0 >> 16); v1[2] += sc0 * bf2f(b1 & 0xffffu); v1[3] += sc0 * bf2f(b1 >> 16); }
                OBW(4 * c) = cvtpk(v0[0], v0[1]); OBW(4 * c + 1) = cvtpk(v0[2], v0[3]); OBW(16 + 4 * c) = cvtpk(v1[0], v1[1]); OBW(16 + 4 * c + 1) = cvtpk(v1[2], v1[3]);
            }
#undef OBW
        };
        merge(cur.A, OA0, OA1, mA, lA);
        if (cur.hasb) merge(cur.B, OB0, OB1, mB, lB);
        if ((u & 3) != 2) {
            __syncthreads();
            if (g == 2) {
                const int tid2 = tid_local(wid_s);
#pragma unroll 1
                for (int j = 0; j < 8; ++j) {
                    const int tl_ = (tid2 >> 3) + 64 * j, c = tid2 & 7;
                    const size_t tok = (size_t)cur.A.b * 4096 + 512 * cur.A.w + tl_;
                    const u32x4 gv = *(const u32x4*)((const bf16_t*)(a.ws + WS_GA) + tok * 512 + cur.A.h * 64 + 8 * c);
                    const LAS unsigned* orw = ob + tl_ * OB_P; const int fs2 = osw(tl_);
                    const unsigned o0 = orw[(4 * c) ^ fs2], o1 = orw[(4 * c + 1) ^ fs2], o2 = orw[(4 * c + 2) ^ fs2], o3 = orw[(4 * c + 3) ^ fs2];
                    u32x4 wv4;
                    wv4.x = cvtpk(bf2f(o0 & 0xffffu) * bf2f(gv.x & 0xffffu), bf2f(o0 >> 16) * bf2f(gv.x >> 16)); wv4.y = cvtpk(bf2f(o1 & 0xffffu) * bf2f(gv.y & 0xffffu), bf2f(o1 >> 16) * bf2f(gv.y >> 16));
                    wv4.z = cvtpk(bf2f(o2 & 0xffffu) * bf2f(gv.z & 0xffffu), bf2f(o2 >> 16) * bf2f(gv.z >> 16)); wv4.w = cvtpk(bf2f(o3 & 0xffffu) * bf2f(gv.w & 0xffffu), bf2f(o3 >> 16) * bf2f(gv.w >> 16));
                    *(u32x4*)((bf16_t*)(a.ws + WS_A1) + tok * 512 + cur.A.h * 64 + 8 * c) = wv4; }
                __syncthreads();
            }
        }
        cur = nxt;
    }
}
}

namespace scan {
constexpr int QT_P = 272, KS_P = 80;
constexpr int OFF_QT = 0, OFF_KT = 8704, OFF_KST = 17408, OFF_VT = 27648, OFF_DEC = 37888, OPB_BYTES = 38400;
constexpr int RAW_GP = 1056;
constexpr int RZ = 0, RV = 8 * RAW_GP, RQ = 16 * RAW_GP;
constexpr int OFF_OPB = 0, OFF_RED = 2 * OPB_BYTES, OFF_RAW = OFF_RED + 512;
constexpr size_t ST_BYTES = 64 * MiB;
constexpr size_t WS_DL = 30 * MiB;
constexpr int OFF_PT = OFF_RAW + 2 * 24 * RAW_GP, PT_P = 72, PT_BYTES = 32 * PT_P, OFF_PCNT = OFF_PT + 2 * PT_BYTES;
constexpr int OFF_STG = OFF_RAW + 3 * 24 * RAW_GP, STG_P = 80;
#define SC_WAITV(n) asm volatile("s_waitcnt vmcnt(" #n ")" ::: "memory")
#define SC_BAR() do { asm volatile("s_waitcnt lgkmcnt(0)" ::: "memory"); __builtin_amdgcn_s_barrier(); asm volatile("" ::: "memory"); } while (0)
template <bool FULL, int DIR> __device__ __forceinline__ void issue_raw(LAS unsigned char* rawb, const bf16_t* hgc  , int w4, int lane) {
#pragma unroll
    for (int i = 0; i < 2; ++i) { const int grp = 2 * w4 + i; const bf16_t* src = hgc + grp * 512 + lane * 8;
        if (FULL) __builtin_amdgcn_global_load_lds((const unsigned*)src, (LAS unsigned*)(rawb + RQ + grp * RAW_GP), 16, 0, 0);
        __builtin_amdgcn_global_load_lds((const unsigned*)(src + 4096 * (1 + DIR)), (LAS unsigned*)(rawb + RZ + grp * RAW_GP), 16, 0, 0);
        __builtin_amdgcn_global_load_lds((const unsigned*)(src + 3 * 4096), (LAS unsigned*)(rawb + RV + grp * RAW_GP), 16, 0, 0); }
}
template <int NI> __device__ __forceinline__ void wait_younger(int y) {
    if (y <= 0) SC_WAITV(0);
    else if (y == 1) { if (NI == 6) SC_WAITV(6); else SC_WAITV(4); }
    else if (y == 2) { if (NI == 6) SC_WAITV(12); else SC_WAITV(8); }
    else { if (NI == 6) SC_WAITV(18); else SC_WAITV(12); }
}
template <bool FULL, int DIR> __device__ __forceinline__ void elem(LAS unsigned char* opb, const LAS unsigned char* rawb, int col0, int tq, int lane, float& gsum0, float& gsum1) {
    unsigned rq[8], rz[8];
#pragma unroll
    for (int t = 0; t < 8; ++t) { const int o = (2 * tq + (t >> 2)) * RAW_GP + (t & 3) * 256 + col0 * 2;
        if (FULL) rq[t] = *(const LAS unsigned*)(rawb + RQ + o); rz[t] = *(const LAS unsigned*)(rawb + RZ + o); }
    float f[2][8], P[2][8], tot[2];
#pragma unroll
    for (int t = 0; t < 8; ++t) { f[0][t] = fast_exp2(h2f((unsigned short)(rz[t] & 0xffffu))); f[1][t] = fast_exp2(h2f((unsigned short)(rz[t] >> 16))); }
#pragma unroll
    for (int c = 0; c < 2; ++c) {
        if (DIR == 0) { P[c][7] = 1.0f;
#pragma unroll
            for (int t = 6; t >= 0; --t) P[c][t] = P[c][t + 1] * f[c][t + 1];
            tot[c] = P[c][0] * f[c][0];
        } else { P[c][0] = 1.0f;
#pragma unroll
            for (int t = 1; t < 8; ++t) P[c][t] = P[c][t - 1] * f[c][t - 1];
            tot[c] = P[c][7] * f[c][7];
        }
    }
    const int cpl = lane & 15;
    float Tq[2][4];
#pragma unroll
    for (int c = 0; c < 2; ++c)
#pragma unroll
        for (int j = 0; j < 4; ++j) Tq[c][j] = shfl_from(tot[c], cpl + 16 * j, lane);
    float post[2], dec[2];
#pragma unroll
    for (int c = 0; c < 2; ++c) {
        if (DIR == 0) post[c] = (tq < 3 ? Tq[c][3] : 1.0f) * (tq < 2 ? Tq[c][2] : 1.0f) * (tq < 1 ? Tq[c][1] : 1.0f);
        else post[c] = (tq > 0 ? Tq[c][0] : 1.0f) * (tq > 1 ? Tq[c][1] : 1.0f) * (tq > 2 ? Tq[c][2] : 1.0f);
        dec[c] = (Tq[c][0] * Tq[c][1]) * (Tq[c][2] * Tq[c][3]);
    }
    unsigned ksw[2][4]; float ksp[2] = {0.f, 0.f};
#pragma unroll
    for (int t = 0; t < 8; ++t) {
        const float P0 = P[0][t] * post[0], P1 = P[1][t] * post[1], ks0 = (1.0f - f[0][t]) * P0, ks1 = (1.0f - f[1][t]) * P1;
        if (FULL) { const float q0 = __uint_as_float(rq[t] << 16) * fast_rcp(P0), q1 = __uint_as_float(rq[t] & 0xffff0000u) * fast_rcp(P1);
            *(LAS unsigned*)(opb + OFF_QT + (8 * tq + t) * QT_P + col0 * 2) = cvtpk(q0, q1);
            *(LAS unsigned*)(opb + OFF_KT + (8 * tq + t) * QT_P + col0 * 2) = cvtpk(ks0, ks1); }
        if (t & 1) { ksw[0][t >> 1] = cvtpk(ksp[0], ks0); ksw[1][t >> 1] = cvtpk(ksp[1], ks1); } else { ksp[0] = ks0; ksp[1] = ks1; } }
    *(LAS u32x4*)(opb + OFF_KST + col0 * KS_P + tq * 16) = (u32x4){ksw[0][0], ksw[0][1], ksw[0][2], ksw[0][3]};
    *(LAS u32x4*)(opb + OFF_KST + (col0 + 1) * KS_P + tq * 16) = (u32x4){ksw[1][0], ksw[1][1], ksw[1][2], ksw[1][3]};
    if (tq == 0) *(LAS f32x2*)(opb + OFF_DEC + col0 * 4) = (f32x2){dec[0], dec[1]};
    if (!FULL) { gsum0 += __builtin_amdgcn_logf(dec[0]); gsum1 += __builtin_amdgcn_logf(dec[1]); }
}
__device__ __forceinline__ void vt_build(LAS unsigned char* opb, const LAS unsigned char* rawb, int col0, int tq) {
    unsigned rv[8];
#pragma unroll
    for (int t = 0; t < 8; ++t) rv[t] = *(const LAS unsigned*)(rawb + RV + (2 * tq + (t >> 2)) * RAW_GP + (t & 3) * 256 + col0 * 2);
    u32x4 v0, v1;
    v0.x = (rv[0] & 0xffffu) | (rv[1] << 16); v0.y = (rv[2] & 0xffffu) | (rv[3] << 16); v0.z = (rv[4] & 0xffffu) | (rv[5] << 16); v0.w = (rv[6] & 0xffffu) | (rv[7] << 16);
    v1.x = (rv[0] >> 16) | (rv[1] & 0xffff0000u); v1.y = (rv[2] >> 16) | (rv[3] & 0xffff0000u); v1.z = (rv[4] >> 16) | (rv[5] & 0xffff0000u); v1.w = (rv[6] >> 16) | (rv[7] & 0xffff0000u);
    *(LAS u32x4*)(opb + OFF_VT + col0 * KS_P + tq * 16) = v0;
    *(LAS u32x4*)(opb + OFF_VT + (col0 + 1) * KS_P + tq * 16) = v1;
}
__device__ __forceinline__ void state_decay(const LAS unsigned char* opb, f32x16 (&S)[4], int hh) {
    f32x4 d4[4][4];
#pragma unroll
    for (int m = 0; m < 4; ++m)
#pragma unroll
        for (int c = 0; c < 4; ++c) d4[m][c] = *(const LAS f32x4*)(opb + OFF_DEC + (32 * m + 8 * c + 4 * hh) * 4);
#pragma unroll
    for (int m = 0; m < 4; ++m)
#pragma unroll
        for (int c = 0; c < 4; ++c) { S[m][4 * c + 0] *= d4[m][c].x; S[m][4 * c + 1] *= d4[m][c].y; S[m][4 * c + 2] *= d4[m][c].z; S[m][4 * c + 3] *= d4[m][c].w; }
}
__device__ __forceinline__ void state_accum(const LAS unsigned char* opb, f32x16 (&S)[4], int n, int r32, int hh) {
    bf16x8 ka[4][2], vb[2];
#pragma unroll
    for (int s = 0; s < 2; ++s) vb[s] = *(const LAS bf16x8*)(opb + OFF_VT + (32 * n + r32) * KS_P + (16 * s + 8 * hh) * 2);
#pragma unroll
    for (int m = 0; m < 4; ++m)
#pragma unroll
        for (int s = 0; s < 2; ++s) ka[m][s] = *(const LAS bf16x8*)(opb + OFF_KST + (32 * m + r32) * KS_P + (16 * s + 8 * hh) * 2);
    __builtin_amdgcn_sched_barrier(0);
    __builtin_amdgcn_s_setprio(1);
#pragma unroll
    for (int m = 0; m < 4; ++m)
#pragma unroll
        for (int s = 0; s < 2; ++s) S[m] = MFMA32(ka[m][s], vb[s], S[m]);
    __builtin_amdgcn_s_setprio(0);
}
template <int DIR> __device__ __forceinline__ void at_build(const LAS unsigned char* opb, LAS unsigned char* pt, LAS unsigned* cnt, int w4, int lane) {
    const int qj = w4 >> 1, qi = w4 & 1, fr = lane & 15, fq = lane >> 4;
    f32x4 acc = {0.f, 0.f, 0.f, 0.f};
    bf16x8 ka[4], qb[4];
#pragma unroll
    for (int ks = 0; ks < 4; ++ks) { ka[ks] = *(const LAS bf16x8*)(opb + OFF_KT + (16 * qj + fr) * QT_P + (32 * ks + 8 * fq) * 2); qb[ks] = *(const LAS bf16x8*)(opb + OFF_QT + (16 * qi + fr) * QT_P + (32 * ks + 8 * fq) * 2); }
#pragma unroll
    for (int ks = 0; ks < 4; ++ks) acc = __builtin_amdgcn_mfma_f32_16x16x32_bf16(ka[ks], qb[ks], acc, 0, 0, 0);
    const int i = 16 * qi + fr, j0 = 16 * qj + 4 * fq;
#pragma unroll
    for (int e = 0; e < 4; ++e) { const bool keep = (DIR == 0) ? (j0 + e <= i) : (j0 + e >= i); acc[e] = keep ? acc[e] : 0.f; }
    u32x2 w; w.x = cvtpk(acc[0], acc[1]); w.y = cvtpk(acc[2], acc[3]);
    *(LAS u32x2*)(pt + i * PT_P + j0 * 2) = w;
    asm volatile("s_waitcnt lgkmcnt(0)" ::: "memory");
    if (lane == 0) __hip_atomic_fetch_add(cnt, 1u, __ATOMIC_RELAXED, __HIP_MEMORY_SCOPE_WORKGROUP);
}
template <int DIR> __device__ __forceinline__ f32x16 chunk_out(const LAS unsigned char* opb, const f32x16 (&S)[4], int n, int r32, int hh, const LAS unsigned char* pt, const LAS unsigned* cnt, unsigned target) {
    const LAS unsigned char* vrow = opb + OFF_VT + (32 * n + r32) * KS_P;
    const LAS unsigned char* qrow = opb + OFF_QT + r32 * QT_P;
    bf16x8 vf[2], qf[4][2];
#pragma unroll
    for (int s = 0; s < 2; ++s) vf[s] = ld8x2(vrow + (16 * s + 4 * hh) * 2, vrow + (16 * s + 8 + 4 * hh) * 2);
#pragma unroll
    for (int m = 0; m < 4; ++m)
#pragma unroll
        for (int s = 0; s < 2; ++s) qf[m][s] = ld8x2(qrow + (32 * m + 16 * s + 4 * hh) * 2, qrow + (32 * m + 16 * s + 8 + 4 * hh) * 2);
    f32x16 o;
#pragma unroll
    for (int i = 0; i < 16; ++i) o[i] = 0.f;
    __builtin_amdgcn_sched_barrier(0);
    __builtin_amdgcn_s_setprio(1);
#pragma unroll
    for (int m = 0; m < 4; ++m) {
        o = MFMA32(pack_step<0>(S[m]), qf[m][0], o);
        o = MFMA32(pack_step<1>(S[m]), qf[m][1], o);
    }
    __builtin_amdgcn_s_setprio(0);
    while ((unsigned)__builtin_amdgcn_readfirstlane((int)*(const volatile LAS unsigned*)cnt) < target) __builtin_amdgcn_s_sleep(1);
    asm volatile("" ::: "memory");
    const LAS unsigned char* prow = pt + r32 * PT_P;
    const bf16x8 p0 = ld8x2(prow + (4 * hh) * 2, prow + (8 + 4 * hh) * 2), p1 = ld8x2(prow + (16 + 4 * hh) * 2, prow + (24 + 4 * hh) * 2);
    __builtin_amdgcn_s_setprio(1);
    o = MFMA32(vf[0], p0, o);
    o = MFMA32(vf[1], p1, o);
    __builtin_amdgcn_s_setprio(0);
    return o;
}
constexpr int NSEG = 4, NCH = 32;
template <int DIR> __device__ __forceinline__ void combine(f32x16 (&S)[4], const float* st, const float* dl, int seg, int n, int lane, int hh) {
    const int cnt = DIR == 0 ? seg : NSEG - 1 - seg;
    for (int k = 0; k < cnt; ++k) { const int sp = DIR == 0 ? k : NSEG - 1 - k;
        const f32x4* stp = (const f32x4*)(st + (size_t)sp * 16384 + n * 4096) + lane; const float* dlp = dl + sp * 128 + 4 * hh;
#pragma unroll
        for (int m = 0; m < 4; ++m)
#pragma unroll
            for (int c = 0; c < 4; ++c) { const f32x4 d4 = *(const f32x4*)(dlp + 32 * m + 8 * c); const f32x4 sv = stp[(m * 4 + c) * 64];
#pragma unroll
                for (int e = 0; e < 4; ++e) S[m][4 * c + e] = S[m][4 * c + e] * fast_exp2(d4[e]) + sv[e]; }
    }
}
template <int MODE, int DIR> __device__ __forceinline__ void sweep(const Args& a, LAS unsigned char* lds, int task, int wid_s) {
    constexpr bool FULL = MODE != 0;
    constexpr int NS = FULL ? 2 : 4, D = NS - 1, NI = FULL ? 6 : 4, RAW_BYTES = (FULL ? 24 : 16) * RAW_GP;
    static_assert(OFF_RAW + NS * RAW_BYTES <= LDS_XB_OFF && OFF_STG + 4 * 32 * STG_P <= LDS_XB_OFF, "scan LDS map");
    const int b = task >> 5, h = (task >> 2) & 7, seg = task & 3;
    const int tidl = tid_local(wid_s), wave = __builtin_amdgcn_readfirstlane(tidl >> 6), w4 = wave & 3, lane = tidl & 63;
    const bool isM = wave >= 4;
    LAS unsigned* pcnt = (LAS unsigned*)(lds + OFF_PCNT);
    if (FULL && tidl == 0) *pcnt = 0u;
    const size_t tokseg = (size_t)b * 4096 + seg * (NCH * 32);
    const bf16_t* hgs = (const bf16_t*)(a.ws + WS_HG) + ((size_t)((b * 8 + h) * 128 + seg * NCH)) * 16384;
    float* stbase = (float*)a.out + ((size_t)((DIR * 64 + b * 8 + h) * NSEG)) * 16384;
    float* dlbase = (float*)(a.ws + WS_DL) + ((size_t)((DIR * 64 + b * 8 + h) * NSEG)) * 128;
#define SC_CH(i) (DIR == 0 ? (i) : NCH - 1 - (i))
    if (!isM) {
        const int tq = lane >> 4, col0 = 32 * w4 + 2 * (lane & 15);
        float gsum0 = 0.f, gsum1 = 0.f;
#pragma unroll
        for (int c = 0; c < D; ++c) issue_raw<FULL, DIR>(lds + OFF_RAW + c * RAW_BYTES, hgs + (size_t)SC_CH(c) * 16384, w4, lane);
        wait_younger<NI>(D - 1);
        SC_BAR();
        for (int i = -1; i < NCH; ++i) {
            if (FULL && i >= 0) at_build<DIR>(lds + OFF_OPB + (i & 1) * OPB_BYTES, lds + OFF_PT + (i & 1) * PT_BYTES, pcnt, w4, lane);
            if (i + 1 < NCH) {
                if (i + 1 + D < NCH) issue_raw<FULL, DIR>(lds + OFF_RAW + ((i + 1 + D) % NS) * RAW_BYTES, hgs + (size_t)SC_CH(i + 1 + D) * 16384, w4, lane);
                elem<FULL, DIR>(lds + OFF_OPB + ((i + 1) & 1) * OPB_BYTES, lds + OFF_RAW + ((i + 1) % NS) * RAW_BYTES, col0, tq, lane, gsum0, gsum1);
                vt_build(lds + OFF_OPB + ((i + 1) & 1) * OPB_BYTES, lds + OFF_RAW + ((i + 1) % NS) * RAW_BYTES, col0, tq);
                if (SC_E2 && FULL) { float d0 = 0.f, d1 = 0.f; elem<FULL, DIR>(lds + OFF_OPB + ((i + 1) & 1) * OPB_BYTES, lds + OFF_RAW + ((i + 1) % NS) * RAW_BYTES, col0, tq, lane, d0, d1); }
                if (i + 2 < NCH) wait_younger<NI>((i + 1 + D < NCH - 1 ? i + 1 + D : NCH - 1) - (i + 2));
            }
            if (MODE == 2 && i >= 0) SC_BAR();
            SC_BAR();
        }
        if (MODE == 0 && tq == 0) *(f32x2*)(dlbase + seg * 128 + col0) = (f32x2){gsum0, gsum1};
    } else {
        const int r32 = lane & 31, hh = lane >> 5, n = w4;
        f32x16 S[4];
#pragma unroll
        for (int m = 0; m < 4; ++m)
#pragma unroll
            for (int i = 0; i < 16; ++i) S[m][i] = 0.f;
        if (MODE != 0) combine<DIR>(S, stbase, dlbase, seg, n, lane, hh);
        bf16_t* a2 = (bf16_t*)(a.ws + WS_A2);
        u32x2* obuf = (u32x2*)((unsigned char*)a.out + ST_BYTES) + ((size_t)(task * NCH) * 16 + n * 4) * 64 + lane;
        const u32x2* gbf = (const u32x2*)(a.ws + WS_GB) + ((size_t)(((b * 8 + h) * 128 + seg * NCH) * 16) + n * 4) * 64 + lane;
        u32x2 obn[4], gvn[4];
        if (MODE == 2) {
#pragma unroll
            for (int c4 = 0; c4 < 4; ++c4) { obn[c4] = obuf[(size_t)SC_CH(0) * 1024 + c4 * 64]; gvn[c4] = gbf[(size_t)SC_CH(0) * 1024 + c4 * 64]; } }
        const int vtq = lane >> 4, vcol0 = 32 * w4 + 2 * (lane & 15);
        SC_BAR();
        SC_BAR();
        for (int i = 0; i < NCH; ++i) {
            const LAS unsigned char* opb = lds + OFF_OPB + (i & 1) * OPB_BYTES;
            state_decay(opb, S, hh);
            if (MODE == 0) { state_accum(opb, S, n, r32, hh); }
            else {
                u32x2 ob[4], gv[4];
                if (MODE == 2) {
#pragma unroll
                    for (int c4 = 0; c4 < 4; ++c4) { ob[c4] = obn[c4]; gv[c4] = gvn[c4]; }
                    if (i + 1 < NCH) {
#pragma unroll
                        for (int c4 = 0; c4 < 4; ++c4) { obn[c4] = obuf[(size_t)SC_CH(i + 1) * 1024 + c4 * 64]; gvn[c4] = gbf[(size_t)SC_CH(i + 1) * 1024 + c4 * 64]; } } }
                f32x16 o = chunk_out<DIR>(opb, S, n, r32, hh, lds + OFF_PT + (i & 1) * PT_BYTES, pcnt, 4u * (unsigned)(i + 1));
                state_accum(opb, S, n, r32, hh);
                if (MODE == 1) {
#pragma unroll
                    for (int c4 = 0; c4 < 4; ++c4) { u32x2 w; w.x = cvtpk(o[4 * c4 + 0], o[4 * c4 + 1]); w.y = cvtpk(o[4 * c4 + 2], o[4 * c4 + 3]); obuf[(size_t)SC_CH(i) * 1024 + c4 * 64] = w; }
                } else {
                    float ss = 0.f;
#pragma unroll
                    for (int c4 = 0; c4 < 4; ++c4) { o[4 * c4 + 0] += bf2f(ob[c4].x & 0xffffu); o[4 * c4 + 1] += bf2f(ob[c4].x >> 16); o[4 * c4 + 2] += bf2f(ob[c4].y & 0xffffu); o[4 * c4 + 3] += bf2f(ob[c4].y >> 16);
                        ss += (o[4 * c4 + 0] * o[4 * c4 + 0] + o[4 * c4 + 1] * o[4 * c4 + 1]) + (o[4 * c4 + 2] * o[4 * c4 + 2] + o[4 * c4 + 3] * o[4 * c4 + 3]); }
                    ss += shflx(ss, 32, lane);
                    LAS float* red = (LAS float*)(lds + OFF_RED);
                    if (hh == 0) red[n * 32 + r32] = ss;
                    f32x4 wn[4];
#pragma unroll
                    for (int c4 = 0; c4 < 4; ++c4) wn[c4] = *(const f32x4*)(a.hg_norm_w + 32 * n + 8 * c4 + 4 * hh);
                    SC_BAR();
                    const float tot = (red[r32] + red[32 + r32]) + (red[64 + r32] + red[96 + r32]);
                    const float rstd = __builtin_amdgcn_rsqf(tot * (1.f / 128.f) + 1e-6f);
                    LAS unsigned char* stg = lds + OFF_STG + n * (32 * STG_P);
#pragma unroll
                    for (int c4 = 0; c4 < 4; ++c4) { u32x2 w;
                        w.x = cvtpk(o[4 * c4 + 0] * rstd * wn[c4].x * bf2f(gv[c4].x & 0xffffu), o[4 * c4 + 1] * rstd * wn[c4].y * bf2f(gv[c4].x >> 16));
                        w.y = cvtpk(o[4 * c4 + 2] * rstd * wn[c4].z * bf2f(gv[c4].y & 0xffffu), o[4 * c4 + 3] * rstd * wn[c4].w * bf2f(gv[c4].y >> 16));
                        *(LAS u32x2*)(stg + r32 * STG_P + (8 * c4 + 4 * hh) * 2) = w; }
                    bf16_t* arow = a2 + (tokseg + (size_t)SC_CH(i) * 32 + (lane >> 2)) * 1024 + h * 128 + 32 * n + (lane & 3) * 8;
#pragma unroll
                    for (int j = 0; j < 2; ++j) { const u32x4 w = *(const LAS u32x4*)(stg + ((lane >> 2) + 16 * j) * STG_P + (lane & 3) * 16); *(u32x4*)(arow + (size_t)j * 16 * 1024) = w; }
                }
            }
            SC_BAR();
        }
        if (MODE == 0) { f32x4* stp = (f32x4*)(stbase + (size_t)seg * 16384 + n * 4096) + lane;
#pragma unroll
            for (int m = 0; m < 4; ++m)
#pragma unroll
                for (int c = 0; c < 4; ++c) stp[(m * 4 + c) * 64] = (f32x4){S[m][4 * c + 0], S[m][4 * c + 1], S[m][4 * c + 2], S[m][4 * c + 3]}; }
    }
#undef SC_CH
}
constexpr int A2_OPB1 = OPB_BYTES - OFF_KST, A2_SLOT1 = OPB_BYTES + A2_OPB1, A2_DIR_BYTES = A2_SLOT1 + 16 * RAW_GP;
static_assert(16 * RAW_GP <= OFF_KST && 2 * A2_DIR_BYTES <= LDS_XB_OFF, "pass A LDS map");
__device__ __forceinline__ void sweep_a2(const Args& a, LAS unsigned char* lds, int task, int wid_s) {
    const int b = task >> 5, h = (task >> 2) & 7, seg = task & 3;
    const int tidl = tid_local(wid_s), wave = __builtin_amdgcn_readfirstlane(tidl >> 6), w4 = wave & 3, dir = wave >> 2, lane = tidl & 63;
    const bf16_t* hgs = (const bf16_t*)(a.ws + WS_HG) + ((size_t)((b * 8 + h) * 128 + seg * NCH)) * 16384;
    float* stbase = (float*)a.out + ((size_t)((dir * 64 + b * 8 + h) * NSEG)) * 16384;
    float* dlbase = (float*)(a.ws + WS_DL) + ((size_t)((dir * 64 + b * 8 + h) * NSEG)) * 128;
    LAS unsigned char* R = lds + dir * A2_DIR_BYTES;
    auto issue = [&](int i) __attribute__((always_inline)) {
        LAS unsigned char* rawb = R + (i & 1) * A2_SLOT1; const bf16_t* hgc = hgs + (size_t)(dir ? NCH - 1 - i : i) * 16384;
#pragma unroll
        for (int k = 0; k < 2; ++k) { const int grp = 2 * w4 + k; const bf16_t* src = hgc + grp * 512 + lane * 8;
            __builtin_amdgcn_global_load_lds((const unsigned*)(src + 4096 * (1 + dir)), (LAS unsigned*)(rawb + RZ + grp * RAW_GP), 16, 0, 0);
            __builtin_amdgcn_global_load_lds((const unsigned*)(src + 3 * 4096), (LAS unsigned*)(rawb + RV + grp * RAW_GP), 16, 0, 0); } };
    const int tq = lane >> 4, col0 = 32 * w4 + 2 * (lane & 15), r32 = lane & 31, hh = lane >> 5, n = w4;
    float gsum0 = 0.f, gsum1 = 0.f;
    f32x16 S[4];
#pragma unroll
    for (int m = 0; m < 4; ++m)
#pragma unroll
        for (int i = 0; i < 16; ++i) S[m][i] = 0.f;
    issue(0);
    SC_WAITV(0);
    SC_BAR();
    auto estage = [&](int i) __attribute__((always_inline)) { LAS unsigned char* opb = R + (i & 1) * A2_OPB1; const LAS unsigned char* rawb = R + (i & 1) * A2_SLOT1;
        if (dir == 0) elem<false, 0>(opb, rawb, col0, tq, lane, gsum0, gsum1); else elem<false, 1>(opb, rawb, col0, tq, lane, gsum0, gsum1);
        vt_build(opb, rawb, col0, tq); };
    auto mstage = [&](int i) __attribute__((always_inline)) { const LAS unsigned char* opp = R + (i & 1) * A2_OPB1; state_decay(opp, S, hh); state_accum(opp, S, n, r32, hh); };
    issue(1); estage(0); SC_WAITV(0); SC_BAR();
    for (int i = 1; i < NCH; ++i) {
        if (i + 1 < NCH) issue(i + 1);
        estage(i);
        mstage(i - 1);
        SC_WAITV(0);
        SC_BAR();
    }
    mstage(NCH - 1);
    if (tq == 0) *(f32x2*)(dlbase + seg * 128 + col0) = (f32x2){gsum0, gsum1};
    { f32x4* stp = (f32x4*)(stbase + (size_t)seg * 16384 + n * 4096) + lane;
#pragma unroll
      for (int m = 0; m < 4; ++m)
#pragma unroll
          for (int c = 0; c < 4; ++c) stp[(m * 4 + c) * 64] = (f32x4){S[m][4 * c + 0], S[m][4 * c + 1], S[m][4 * c + 2], S[m][4 * c + 3]}; }
}
}

#define XB_TMO      128
#define XB_XCNT(j)  (256  + 64 * (j))
#define XB_XSUB(j)  (1280 + 64 * (j))
#define XB_XGEN(j)  (2304 + 64 * (j))
#define XB_TOP      3328
#define XB_TOPGEN   3392
#define XCD_BAR_WORDS 3456
#define XB_SPIN_CAP (1u << 18)
constexpr int CTL_ZERO_BYTES = 16384;
__device__ __forceinline__ unsigned xb_ld(unsigned* p)              { return __hip_atomic_load(p, __ATOMIC_RELAXED, __HIP_MEMORY_SCOPE_AGENT); }
__device__ __forceinline__ unsigned xb_add(unsigned* p, unsigned v) { return __hip_atomic_fetch_add(p, v, __ATOMIC_RELAXED, __HIP_MEMORY_SCOPE_AGENT); }
__device__ __forceinline__ unsigned xb_xcc_id() { return (unsigned)__builtin_amdgcn_s_getreg((3 << 11) | 20) & 0xFu; }
#define XB_SPIN(cond, bar) do { unsigned _sp = 0; while (cond) { __builtin_amdgcn_s_sleep(1); \
    if ((++_sp & 255u) == 0u) { if (xb_ld(&(bar)[XB_TMO])) break; if (_sp > XB_SPIN_CAP) { atomicAdd(&(bar)[XB_TMO], 1u); break; } } } } while (0)
struct XcdBarrier { unsigned* bar; unsigned x; volatile LAS unsigned* st; };
__device__ __forceinline__ XcdBarrier xcd_barrier_post(unsigned* bar, volatile LAS unsigned* st) {
    XcdBarrier b; b.bar = bar; b.x = xb_xcc_id(); b.st = st;
    if (threadIdx.x == 0) (void)xb_add(&bar[XB_XCNT(b.x)], 1u);
    return b;
}
__device__ __forceinline__ void xcd_barrier_complete(unsigned* bar, unsigned x, unsigned& nloc, unsigned& nx) {
    const unsigned G = gridDim.x * gridDim.y * gridDim.z;
    unsigned sum, cnt, mine, sp = 0u;
    for (;;) {
        sum = 0u; cnt = 0u; mine = 0u;
#pragma unroll
        for (unsigned j = 0; j < 16; ++j) { const unsigned c = xb_ld(&bar[XB_XCNT(j)]); sum += c; cnt += (c > 0u) ? 1u : 0u; mine = (j == x) ? c : mine; }
        if (sum == G) break;
        __builtin_amdgcn_s_sleep(1);
        if ((++sp & 255u) == 0u) { if (xb_ld(&bar[XB_TMO])) break; if (sp > XB_SPIN_CAP) { atomicAdd(&bar[XB_TMO], 1u); break; } }
    }
    nloc = mine > 0u ? mine : 1u; nx = cnt > 0u ? cnt : 1u;
}
__device__ __forceinline__ void xcd_barrier(const XcdBarrier& b, int wid_s) {
    asm volatile("s_waitcnt vmcnt(0)" ::: "memory");
    __syncthreads();
    if (wid_s == 0 && lane_fresh() == 0) {
        unsigned* bar = b.bar;
        __builtin_amdgcn_s_waitcnt(0);
        unsigned nloc = b.st[0], nx = b.st[1];
        if (nloc == 0u) { xcd_barrier_complete(bar, b.x, nloc, nx); b.st[0] = nloc; b.st[1] = nx; }
        const unsigned old = xb_add(&bar[XB_XSUB(b.x)], 1u);
        const unsigned gen = old / nloc;
        if (old + 1u == (gen + 1u) * nloc) {
            __builtin_amdgcn_fence(__ATOMIC_RELEASE, "agent");
            asm volatile("s_waitcnt vmcnt(0)" ::: "memory");
            const unsigned og = xb_add(&bar[XB_TOP], 1u);
            const unsigned tg = og / nx;
            if (og + 1u == (tg + 1u) * nx) xb_add(&bar[XB_TOPGEN], 1u);
            else XB_SPIN(xb_ld(&bar[XB_TOPGEN]) == tg, bar);
            __builtin_amdgcn_fence(__ATOMIC_ACQUIRE, "agent");
            xb_add(&bar[XB_XGEN(b.x)], 1u);
            asm volatile("s_waitcnt vmcnt(0)" ::: "memory");
        } else {
            XB_SPIN(xb_ld(&bar[XB_XGEN(b.x)]) == gen, bar);
            __builtin_amdgcn_fence(__ATOMIC_ACQUIRE, "agent");
            asm volatile("s_waitcnt vmcnt(0)" ::: "memory");
        }
    }
    __syncthreads();
}

typedef const __attribute__((address_space(4))) Args* kargs_t;
__device__ __forceinline__ Args ldargs(kargs_t p) {
#if defined(__HIP_DEVICE_COMPILE__)
    asm volatile("" : "+s"(p)); return *p;
#else
    return Args{};
#endif
}
__global__ void __launch_bounds__(NTHREADS, 2) fwd_megakernel(Args a_unused) {
    extern __shared__ __attribute__((aligned(16))) unsigned char lds_raw[];
    LAS unsigned char* lds = (LAS unsigned char*)lds_raw;
    cg::grid_group grid = cg::this_grid();
    kargs_t kp = (kargs_t)__builtin_amdgcn_kernarg_segment_ptr();
    const int G = gridDim.x, bx = blockIdx.x;
    const int wid_s = __builtin_amdgcn_readfirstlane((int)threadIdx.x >> 6);
    const int vcu = (bx % 8) * (G / 8) + bx / 8;
    if (threadIdx.x < 16) ((LAS unsigned*)(lds + LDS_XB_OFF))[threadIdx.x] = 0u;
    __syncthreads();
    if (bx == 0) { const Args a = ldargs(kp); unsigned* ctl = (unsigned*)a.ws; for (int i = threadIdx.x; i < XCD_BAR_WORDS; i += NTHREADS) __hip_atomic_store(ctl + i, 0u, __ATOMIC_RELAXED, __HIP_MEMORY_SCOPE_AGENT); }
    grid.sync();
    XcdBarrier xbar; { const Args a = ldargs(kp); xbar = xcd_barrier_post((unsigned*)a.ws, (volatile LAS unsigned*)(lds + LDS_XB_OFF)); }

#define GSYNC() do { for (int _r = 0; _r < REP_SYNC; ++_r) xcd_barrier(xbar, wid_s); } while (0)
    for (int rep = 0; rep < REP_P0; ++rep) { const Args a = ldargs(kp); p0_prologue(a, lds, vcu, G, wid_s); }
    GSYNC();
    for (int rep = 0; rep < REP_P1; ++rep) { const Args a = ldargs(kp); unsigned char* ws = a.ws;
      EpiIn ein; ein.wsb = ws; ein.qkv = (bf16_t*)(ws + WS_QKV); ein.zg = (bf16_t*)a.out; ein.qnw = a.q_norm_w; ein.knw = a.k_norm_w; ein.lbf = a.lb_fwd; ein.lbb = a.lb_bwd; ein.pn0 = 0;
      pg8::Gemm g{(const bf16_t*)(ws + WS_H), (const bf16_t*)(ws + WS_WIN), MTOK, 20 * 256, 1024, STAGGER}; pg8::StaticOrder S; S.init(MTOK, 20 * 256, G, bx);
      pg8::gemm_phase<EpiIn, pg8::StaticOrder, P1_ALIGN, true, COVER_P1>(lds, g, S, ein, wid_s); }
    GSYNC();
    for (int rep = 0; rep < REP_ATT; ++rep) { const Args a = ldargs(kp); attn::phase(a, lds, vcu, wid_s); __syncthreads(); }
    GSYNC();
    for (int rep = 0; rep < REP_P1; ++rep) { const Args a = ldargs(kp); unsigned char* ws = a.ws;
      EpiIn ein; ein.wsb = ws; ein.qkv = (bf16_t*)(ws + WS_QKV); ein.zg = (bf16_t*)a.out; ein.qnw = a.q_norm_w; ein.knw = a.k_norm_w; ein.lbf = a.lb_fwd; ein.lbb = a.lb_bwd; ein.pn0 = 20;
      pg8::Gemm g{(const bf16_t*)(ws + WS_H), (const bf16_t*)(ws + WS_WIN) + (size_t)20 * 256 * 1024, MTOK, 20 * 256, 1024, STAGGER}; pg8::StaticOrder S; S.init(MTOK, 20 * 256, G, bx);
      pg8::gemm_phase<EpiIn, pg8::StaticOrder, P1_ALIGN, true, COVER_P1>(lds, g, S, ein, wid_s); }
    GSYNC();
    for (int rep = 0; rep < REP_SCA; ++rep) { const Args a = ldargs(kp); scan::sweep_a2(a, lds, vcu, wid_s); }
    GSYNC();
    for (int rep = 0; rep < REP_SCC; ++rep) { { const Args a = ldargs(kp); scan::sweep<1, 1>(a, lds, vcu, wid_s); } { const Args a = ldargs(kp); scan::sweep<2, 0>(a, lds, vcu, wid_s); } }
    GSYNC();
    for (int rep = 0; rep < REP_P3; ++rep) { const Args a = ldargs(kp); unsigned char* ws = a.ws; pg8::StaticOrder S; S.init(MTOK, 1024, G, bx);
      { const bf16_t* gw = (const bf16_t*)(ws + WS_WIN) + (size_t)40 * 256 * 1024; const bf16_t* Hh = (const bf16_t*)(ws + WS_H);
        pg8::Gemm4 g4{{Hh, Hh, (const bf16_t*)(ws + WS_A1), (const bf16_t*)(ws + WS_A2)}, {gw, gw, (const bf16_t*)(ws + WS_WA), (const bf16_t*)(ws + WS_WB)}, {1024, 1024, 512, 1024}, {4, 0, 0, 0}};
        EpiP3 E{EpiSig{(bf16_t*)(ws + WS_T1), (bf16_t*)(ws + WS_T2)}, EpiY2{(const bf16_t*)(ws + WS_T1), (const bf16_t*)(ws + WS_T2), (bf16_t*)(ws + WS_MG)}};
        pg8::gemm_phase4<EpiP3, pg8::StaticOrder>(lds, g4, S, E, wid_s); } }
    GSYNC();
    for (int rep = 0; rep < REP_P4; ++rep) { const Args a = ldargs(kp); unsigned char* ws = a.ws;
      pg8::Gemm g{(const bf16_t*)(ws + WS_MG), (const bf16_t*)(ws + WS_WO), MTOK, 1024, 1024}; pg8::StaticOrder S; S.init(MTOK, 1024, G, bx); EpiOut E{a.x, a.out};
      pg8::gemm_phase<EpiOut, pg8::StaticOrder, true, true>(lds, g, S, E, wid_s); }
}

extern "C" void kernel_launch(void* const* d_in, const int* in_sizes, int n_in, void* d_out, int out_size, void* d_ws, size_t ws_size, hipStream_t stream) {
    static int grid = 0;
    if (grid == 0) {
        if (n_in != 12 || in_sizes[0] != MTOK * DM || out_size != MTOK * DM || ws_size < WS_END) { fprintf(stderr, "kernel_launch: unexpected shapes (n_in %d, ws %zu)\n", n_in, ws_size); grid = -1; return; }
        int dev = 0, cus = 0, per_cu = 0;
        if (hipGetDevice(&dev) != hipSuccess || hipDeviceGetAttribute(&cus, hipDeviceAttributeMultiprocessorCount, dev) != hipSuccess) { grid = -1; return; }
        if (hipFuncSetAttribute((const void*)fwd_megakernel, hipFuncAttributeMaxDynamicSharedMemorySize, LDS_BYTES) != hipSuccess) { fprintf(stderr, "hipFuncSetAttribute failed\n"); grid = -1; return; }
        if (hipOccupancyMaxActiveBlocksPerMultiprocessor(&per_cu, (const void*)fwd_megakernel, NTHREADS, LDS_BYTES) != hipSuccess || per_cu < 1) { fprintf(stderr, "occupancy query: %d\n", per_cu); (void)hipGetLastError(); }
        grid = cus;
        if (grid != 256) { fprintf(stderr, "kernel_launch: built for a 256-CU device (got %d)\n", cus); grid = -1; return; }
    }
    if (grid < 0) return;
    Args a{};
    a.x = (const float*)d_in[0]; a.norm_w = (const float*)d_in[1]; a.w_in = (const float*)d_in[2]; a.q_norm_w = (const float*)d_in[3]; a.k_norm_w = (const float*)d_in[4]; a.rel_bias = (const float*)d_in[5];
    a.lb_fwd = (const float*)d_in[6]; a.lb_bwd = (const float*)d_in[7]; a.hg_norm_w = (const float*)d_in[8]; a.w_proj_a = (const float*)d_in[9]; a.w_proj_b = (const float*)d_in[10]; a.w_out = (const float*)d_in[11];
    a.out = (float*)d_out; a.ws = (unsigned char*)d_ws;
    void* args[] = {&a};
    hipError_t e = hipLaunchCooperativeKernel((void*)fwd_megakernel, dim3(grid), dim3(NTHREADS), args, LDS_BYTES, stream);
    if (e != hipSuccess) fprintf(stderr, "cooperative launch failed: %s (grid %d)\n", hipGetErrorString(e), grid);
}
```
